# Optimizing an MI355X kernel written in HIP

```python
import jax
import jax.numpy as jnp
from jax import lax
import numpy as np

D_MODEL = 1024
BATCH = 16
SEQ = 2048
DEPTH = 1
DEC_BATCH = 8
DEC_SEQ = 4096
PAST_LEN = 128

RET_HEADS = 8
RET_DK = 64
RET_DV = 64
RET_WIDTH = RET_HEADS * RET_DV
RET_CHUNK = 128
ROPE_BASE = 10000.0
HG_HEADS = 4
HG_DK = 128
HG_DV = 128
HG_KDIM = HG_HEADS * HG_DK
HG_WIDTH = HG_HEADS * HG_DV
HG_CHUNK = 64
HG_SUB = 8
D_FF = 2816
CONV_W = 3
EPS = 1e-6
IN_SPLITS = (RET_HEADS * RET_DK, RET_HEADS * RET_DK, RET_WIDTH, RET_WIDTH,
             HG_KDIM, HG_KDIM, HG_KDIM, HG_WIDTH, HG_WIDTH, D_MODEL, D_MODEL)
D_IN = 2 * RET_HEADS * RET_DK + 2 * RET_WIDTH + 3 * HG_KDIM + 2 * HG_WIDTH + 2 * D_MODEL
F32 = jnp.float32

kernel_name = "hybrid_retention_hgrn2_convffn_encoder"


def rmsnorm(x, w):
    xf = x.astype(F32)
    y = xf * lax.rsqrt(jnp.mean(xf * xf, axis=-1, keepdims=True) + EPS)
    return (y * w.astype(F32)).astype(x.dtype)


def head_rms(o):
    return o * lax.rsqrt(jnp.mean(o * o, axis=-1, keepdims=True) + EPS)


def split_heads(t, n_heads):
    b, l, _ = t.shape
    return t.reshape(b, l, n_heads, -1).transpose(0, 2, 1, 3).astype(F32)


def merge_heads(t):
    b, h, l, d = t.shape
    return t.transpose(0, 2, 1, 3).reshape(b, l, h * d)


def to_chunks(t, c):
    b, h, l, d = t.shape
    return t.reshape(b, h, l // c, c, d)


def flip_seq(t):
    return jnp.flip(t, axis=2)


def rotary(x):
    l, d = x.shape[-2], x.shape[-1]
    half = d // 2
    inv_freq = ROPE_BASE ** (-jnp.arange(half, dtype=F32) / half)
    ang = jnp.arange(l, dtype=F32)[:, None] * inv_freq[None, :]
    cos, sin = jnp.cos(ang), jnp.sin(ang)
    x1, x2 = x[..., :half], x[..., half:]
    return jnp.concatenate([x1 * cos - x2 * sin, x1 * sin + x2 * cos], axis=-1)


def chunk_state_scan(decay, ds):
    def step(s, inp):
        a, d = inp
        return a * s + d, s
    _, prev = lax.scan(step, jnp.zeros(ds.shape[1:], ds.dtype), (decay, ds))
    return prev


def retention_dir(q, k, v, log_gamma, inclusive):
    C = RET_CHUNK
    qc, kc, vc = to_chunks(q, C), to_chunks(k, C), to_chunks(v, C)
    idx = jnp.arange(C, dtype=F32)
    lg = log_gamma[:, None, None]
    diff = idx[:, None] - idx[None, :]
    mask = (diff >= 0) if inclusive else (diff > 0)
    dmat = jnp.where(mask, jnp.exp(jnp.where(mask, diff, 0.0) * lg), 0.0)
    scores = jnp.einsum('bhnid,bhnjd->bhnij', qc, kc) * dmat[None, :, None]
    o_intra = jnp.einsum('bhnij,bhnje->bhnie', scores, vc)
    k_w = kc * jnp.exp((C - 1.0 - idx)[:, None] * lg)[None, :, None]
    ds = jnp.einsum('bhncd,bhnce->bhnde', k_w, vc)
    ds_n = jnp.moveaxis(ds, 2, 0)
    decay = jnp.broadcast_to(jnp.exp(C * log_gamma)[None, None, :, None, None],
                             (ds_n.shape[0], 1, ds_n.shape[2], 1, 1))
    prev = jnp.moveaxis(chunk_state_scan(decay, ds_n), 0, 2)
    q_w = qc * jnp.exp((idx + 1.0)[:, None] * lg)[None, :, None]
    o_cross = jnp.einsum('bhncd,bhnde->bhnce', q_w, prev)
    return (o_intra + o_cross).reshape(v.shape)


def hgrn2_dir(q, k, v, g):
    C, c = HG_CHUNK, HG_SUB
    ns = C // c
    qc, kc, vc, gc = [to_chunks(t, C) for t in (q, k, v, g)]
    b = jnp.cumsum(gc, axis=-2)
    b_last = b[..., -1:, :]
    ds = jnp.einsum('bhncd,bhnce->bhnde', kc * jnp.exp(b_last - b), vc)
    decay = jnp.swapaxes(jnp.moveaxis(jnp.exp(b_last), 2, 0), -1, -2)
    prev = jnp.moveaxis(chunk_state_scan(decay, jnp.moveaxis(ds, 2, 0)), 0, 2)
    o_cross = jnp.einsum('bhncd,bhnde->bhnce', qc * jnp.exp(b), prev)
    sh = qc.shape[:3] + (ns, c, qc.shape[-1])
    qs, ks, bs = qc.reshape(sh), kc.reshape(sh), b.reshape(sh)
    vs = vc.reshape(qc.shape[:3] + (ns, c, vc.shape[-1]))
    b_start = jnp.concatenate([jnp.zeros_like(bs[..., :1, -1:, :]), bs[..., :-1, -1:, :]],
                              axis=-3)
    q_t = qs * jnp.exp(bs - b_start)
    before = jnp.arange(C)[None, :] < (jnp.arange(ns) * c)[:, None]
    rel = b_start - b[..., None, :, :]
    k_t = kc[..., None, :, :] * jnp.where(before[:, :, None], jnp.exp(jnp.minimum(rel, 0.0)), 0.0)
    a_inter = jnp.einsum('bhnaid,bhnajd->bhnaij', q_t, k_t)
    o_inter = jnp.einsum('bhnaij,bhnje->bhnaie', a_inter, vc)
    tri = jnp.arange(c)[:, None] >= jnp.arange(c)[None, :]
    rel_d = bs[..., :, None, :] - bs[..., None, :, :]
    dec = jnp.where(tri[..., None], jnp.exp(jnp.minimum(rel_d, 0.0)), 0.0)
    a_diag = jnp.einsum('bhnaid,bhnajd,bhnaijd->bhnaij', qs, ks, dec)
    o_diag = jnp.einsum('bhnaij,bhnaje->bhnaie', a_diag, vs)
    o_sub = (o_inter + o_diag).reshape(vc.shape)
    return (o_cross + o_sub).reshape(v.shape)


def token_mixer(hn, w_in, lb, w_ret_norm, w_hg_norm, w_ret_up, w_hg_up, w_out):
    dt = hn.dtype
    proj = hn @ w_in
    offsets = np.cumsum(IN_SPLITS)[:-1].tolist()
    rq, rk, rv, rg, hq, hf_fwd, hf_bwd, hi, hg, ga, gb = jnp.split(proj, offsets, axis=-1)

    q = rotary(split_heads(rq, RET_HEADS))
    k = rotary(split_heads(rk, RET_HEADS)) * RET_DK ** -0.5
    v = split_heads(rv, RET_HEADS)
    log_gamma = jnp.log(1.0 - 2.0 ** (-5.0 - jnp.arange(RET_HEADS, dtype=F32)))
    o_ret = (retention_dir(q, k, v, log_gamma, True)
             + flip_seq(retention_dir(flip_seq(q), flip_seq(k), flip_seq(v), log_gamma, False)))
    ret = merge_heads(head_rms(o_ret)) * w_ret_norm.astype(F32) * jax.nn.silu(rg.astype(F32))

    q2 = jax.nn.silu(split_heads(hq, HG_HEADS))
    i2 = split_heads(hi, HG_HEADS)

    def forget(pre, lower):
        f = lower + (1.0 - lower) * jax.nn.sigmoid(pre.astype(F32))
        return split_heads(1.0 - f, HG_HEADS), split_heads(jnp.log(f), HG_HEADS)

    k_f, g_f = forget(hf_fwd, lb[0])
    k_b, g_b = forget(hf_bwd, lb[1])
    o_hg = (hgrn2_dir(q2, k_f, i2, g_f)
            + flip_seq(hgrn2_dir(flip_seq(q2), flip_seq(k_b), flip_seq(i2), flip_seq(g_b))))
    hgo = merge_heads(head_rms(o_hg)) * w_hg_norm.astype(F32) * jax.nn.silu(hg.astype(F32))

    merged = (jax.nn.sigmoid(ga.astype(F32)) * (ret.astype(dt) @ w_ret_up).astype(F32)
              + jax.nn.sigmoid(gb.astype(F32)) * (hgo.astype(dt) @ w_hg_up).astype(F32))
    return merged.astype(dt) @ w_out


def conv_ffn(hn, w_ffn_in, conv_w, conv_b, w_ffn_down):
    dt = hn.dtype
    u, v = jnp.split(hn @ w_ffn_in, 2, axis=-1)
    pad = CONV_W // 2
    up = jnp.pad(u, ((0, 0), (pad, pad), (0, 0)))
    L = u.shape[1]
    uc = conv_b
    for t in range(CONV_W):
        uc = uc + up[:, t:t + L] * conv_w[t]
    return (jax.nn.gelu(uc) * v).astype(dt) @ w_ffn_down


def encode(x, w_in, lower_bounds, w_ret_norm, w_hg_norm, w_ret_up, w_hg_up, w_out,
           norm_mix, norm_ffn, w_ffn_in, conv_w, conv_b, w_ffn_down, norm_final):
    lbs = jnp.cumsum(jax.nn.softmax(lower_bounds.astype(F32), axis=0), axis=0)
    h = x
    for l in range(DEPTH):
        h = h + token_mixer(rmsnorm(h, norm_mix[l]), w_in[l], lbs[l], w_ret_norm[l],
                            w_hg_norm[l], w_ret_up[l], w_hg_up[l], w_out[l])
        h = h + conv_ffn(rmsnorm(h, norm_ffn[l]), w_ffn_in[l], conv_w[l], conv_b[l],
                         w_ffn_down[l])
    return rmsnorm(h, norm_final)


def setup_inputs(seed: int = 0) -> dict:
    key = jax.random.key(seed)
    ks = jax.random.split(key, 16)

    def dense(k, shape, fan_in):
        return jax.random.normal(k, shape, F32) * fan_in ** -0.5

    def gain(k, shape):
        return 1.0 + 0.02 * jax.random.normal(k, shape, F32)

    return {
        "x_prompt": jax.random.normal(ks[0], (BATCH, SEQ, D_MODEL), F32),
        "x_sample": jax.random.normal(ks[1], (DEC_BATCH, DEC_SEQ, D_MODEL), F32),
        "w_in": dense(ks[2], (DEPTH, D_MODEL, D_IN), D_MODEL),
        "lower_bounds": 0.1 * jax.random.normal(ks[3], (DEPTH + 1, 2, HG_KDIM), F32),
        "w_ret_norm": gain(ks[4], (DEPTH, RET_WIDTH)),
        "w_hg_norm": gain(ks[5], (DEPTH, HG_WIDTH)),
        "w_ret_up": dense(ks[6], (DEPTH, RET_WIDTH, D_MODEL), RET_WIDTH),
        "w_hg_up": dense(ks[7], (DEPTH, HG_WIDTH, D_MODEL), HG_WIDTH),
        "w_out": dense(ks[8], (DEPTH, D_MODEL, D_MODEL), D_MODEL),
        "norm_mix": gain(ks[9], (DEPTH, D_MODEL)),
        "norm_ffn": gain(ks[10], (DEPTH, D_MODEL)),
        "w_ffn_in": dense(ks[11], (DEPTH, D_MODEL, 2 * D_FF), D_MODEL),
        "conv_w": dense(ks[12], (DEPTH, CONV_W, D_FF), CONV_W),
        "conv_b": 0.01 * jax.random.normal(ks[13], (DEPTH, D_FF), F32),
        "w_ffn_down": dense(ks[14], (DEPTH, D_FF, D_MODEL), D_FF),
        "norm_final": gain(ks[15], (D_MODEL,)),
    }


def reference(x_prompt, x_sample, w_in, lower_bounds, w_ret_norm, w_hg_norm, w_ret_up,
              w_hg_up, w_out, norm_mix, norm_ffn, w_ffn_in, conv_w, conv_b, w_ffn_down,
              norm_final):
    y_prompt = encode(x_prompt, w_in, lower_bounds, w_ret_norm, w_hg_norm, w_ret_up, w_hg_up,
                      w_out, norm_mix, norm_ffn, w_ffn_in, conv_w, conv_b, w_ffn_down,
                      norm_final)
    y_sample = encode(x_sample, w_in, lower_bounds, w_ret_norm, w_hg_norm, w_ret_up, w_hg_up,
                      w_out, norm_mix, norm_ffn, w_ffn_in, conv_w, conv_b, w_ffn_down,
                      norm_final)
    return (y_prompt, y_sample)
```

```cpp
#include <hip/hip_runtime.h>
#include <hip/hip_cooperative_groups.h>
#include <cstdio>
#include <cstdint>
namespace cg = cooperative_groups;

#ifndef MK_COOP
#define MK_COOP 1
#endif

#define LAS __attribute__((address_space(3)))
#define DI __device__ __forceinline__
typedef unsigned short bf16_t;
typedef short bf16x8 __attribute__((ext_vector_type(8)));
typedef float f32x4 __attribute__((ext_vector_type(4)));
typedef unsigned u32x4 __attribute__((ext_vector_type(4)));
typedef unsigned u32x2 __attribute__((ext_vector_type(2)));

constexpr int D = 1024, DIN = 6656, DFF = 2816, NFF2 = 5632;
constexpr int MH = 32768;
constexpr float EPS = 1e-6f;
constexpr int NTHREADS = 512;
constexpr int C_RQ = 0, C_RK = 512, C_RV = 1024, C_RG = 1536, C_HQ = 2048, C_HFF = 2560, C_HFB = 3072, C_HI = 3584, C_HG = 4096, C_GA = 4608, C_GB = 5632;

__device__ __forceinline__ float lg2gamma(int h) {
    float r = -0.04580368961312479f;
    r = h == 1 ? -0.02272007650008353f : r; r = h == 2 ? -0.011315313227834146f : r; r = h == 3 ? -0.005646563141142063f : r;
    r = h == 4 ? -0.0028205190623786626f : r; r = h == 5 ? -0.0014095702546713536f : r; r = h == 6 ? -0.0007046129765893727f : r; r = h == 7 ? -0.0003522634716290214f : r;
    return r;
}

constexpr size_t MiB = 1u << 20;
constexpr size_t WS_OML = 0;
constexpr size_t WS_ROT = 1 * MiB;
constexpr size_t WS_WIN = 2 * MiB;
constexpr size_t WS_WR = 15 * MiB;
constexpr size_t WS_WH = 16 * MiB;
constexpr size_t WS_WO = 17 * MiB;
constexpr size_t WS_WF = 19 * MiB;
constexpr size_t WS_WD = 30 * MiB;
constexpr size_t WS_HN = 36 * MiB;
constexpr size_t WS_SS1 = 164 * MiB;
constexpr size_t WS_SS2 = 168 * MiB;
constexpr size_t WS_HE = 168 * MiB;
constexpr size_t WS_RSRAW = 170 * MiB;
constexpr size_t WS_RST = 202 * MiB;
constexpr size_t WS_HST = 234 * MiB;
constexpr size_t WS_PJ = 362 * MiB;
constexpr size_t WS_GT = 650 * MiB;
constexpr size_t WS_G = 426 * MiB;
constexpr size_t WS_RET = 778 * MiB;
constexpr size_t WS_MG = 170 * MiB;
constexpr size_t WS_A2 = 298 * MiB;
constexpr size_t WS_SIDE = 970 * MiB;
constexpr size_t WS_END = 990 * MiB;

constexpr size_t WS_CNT = 131072;
constexpr size_t WS_BAR = 65536;
constexpr size_t PJ_HG0 = (size_t)2048 * MH, PJ_G0 = (size_t)4608 * MH;
__host__ __device__ __forceinline__ size_t pj_ret(int stream, int hd) { return ((size_t)(stream * 8 + hd) * MH) * 64; }
__host__ __device__ __forceinline__ size_t pj_hg(int stream, int hd) { return PJ_HG0 + ((size_t)(stream * 4 + hd) * MH) * 128; }
constexpr int LDS_BYTES = 147456;
constexpr int LDS_BARW = 147456 - 64;

DI float bf2f(unsigned short b) { return __uint_as_float((unsigned)b << 16); }
DI float bflo(unsigned u) { return __uint_as_float(u << 16); }
DI float bfhi(unsigned u) { return __uint_as_float(u & 0xffff0000u); }
typedef __bf16 bf16v2_t __attribute__((ext_vector_type(2)));
DI unsigned pk2(float lo, float hi) { bf16v2_t v; v[0] = (__bf16)lo; v[1] = (__bf16)hi; return __builtin_bit_cast(unsigned, v); }
DI unsigned short f2bf(float f) { return (unsigned short)(pk2(f, 0.f) & 0xffffu); }
DI float sigm(float x) { return __builtin_amdgcn_rcpf(1.f + __builtin_amdgcn_exp2f(-1.4426950408889634f * x)); }
DI f32x4 sig4_exp2(f32x4 t) {
    f32x4 d;
#pragma unroll
    for (int j = 0; j < 4; ++j) d[j] = 1.f + __builtin_amdgcn_exp2f(fminf(t[j], 28.853900817779268f));
    const float p01 = d[0] * d[1], p23 = d[2] * d[3];
    const float rr = __builtin_amdgcn_rcpf(p01 * p23);
    const float r01 = rr * p23, r23 = rr * p01;
    return (f32x4){r01 * d[1], r01 * d[0], r23 * d[3], r23 * d[2]};
}
DI int opaque(int x) { asm volatile("" : "+v"(x)); return x; }
DI float wave_sum(float v) {
#pragma unroll
    for (int o = 1; o < 64; o <<= 1) v += __shfl_xor(v, o);
    return v;
}
DI u32x4 pack8(const f32x4 a, const f32x4 b) { u32x4 w; w.x = pk2(a[0], a[1]); w.y = pk2(a[2], a[3]); w.z = pk2(b[0], b[1]); w.w = pk2(b[2], b[3]); return w; }
DI void unpack8(const u32x4 w, f32x4& a, f32x4& b) { a = (f32x4){bflo(w.x), bfhi(w.x), bflo(w.y), bfhi(w.y)}; b = (f32x4){bflo(w.z), bfhi(w.z), bflo(w.w), bfhi(w.w)}; }
#define MFMA16(a, b, c) __builtin_amdgcn_mfma_f32_16x16x32_bf16((a), (b), (c), 0, 0, 0)

namespace pg8 {
constexpr int BM = 256, BK = 64, HALF = 128, HTB = HALF * BK * 2, STAGE_BYTES = 8 * HTB, NXCD = 8, WGM = 8;
__host__ __device__ __forceinline__ int lds_byte(int r, int c) { const int st = (r >> 4) * 2 + (c >> 5), rr = r & 15, cc = c & 31, ob = rr * 64 + cc * 2; return st * 1024 + (ob ^ (((ob >> 9) & 1) << 5)); }
__host__ __device__ __forceinline__ void stage_rc(int b, int& R, int& C) { const int st = b / 1024, sb = b % 1024, swz = sb ^ (((sb >> 9) & 1) << 5); R = (st >> 1) * 16 + swz / 64; C = (st & 1) * 32 + (swz % 64) / 2; }
__host__ __device__ __forceinline__ int perm32(int rho) { const int n = rho >> 4, i = rho & 15; return 8 * (i >> 2) + 4 * n + (i & 3); }

struct Unit { int pm, pn; };
struct Gemm { const bf16_t* A; const bf16_t* Bt; int M, N, K; };

struct StaticOrder {
    int nM, nN, nwg, G, c;
    __host__ __device__ void init(int M, int N, int G_, int c_) { nM = M / BM; nN = N / BM; nwg = nM * nN; G = G_; c = c_; }
    __host__ __device__ bool next(int i, Unit& u) const {
        const long L = (long)i * G + c; if (L >= nwg) return false;
        int wgid = (int)L; { const int q = nwg / NXCD, r = nwg % NXCD, xcd = wgid % NXCD, off = wgid / NXCD; wgid = (xcd < r ? xcd * (q + 1) : r * (q + 1) + (xcd - r) * q) + off; }
        const int nig = WGM * nN, gid = wgid / nig, fm = gid * WGM, gsz = (nM - fm) < WGM ? (nM - fm) : WGM;
        u.pm = fm + ((wgid % nig) % gsz); u.pn = (wgid % nig) / gsz; return true;
    }
    __device__ __forceinline__ void a_ready(const Unit&) const {}
    __device__ __forceinline__ void done(const Unit&) const {}
};

template <class Epi, class Sched, bool ALIGN_EPI = false, bool SP2 = false>
__device__ __forceinline__ void gemm_phase(LAS unsigned char* lds, const Gemm g, const Sched& S, const Epi& E) {
    const int tid = opaque(threadIdx.x), wid = __builtin_amdgcn_readfirstlane(tid >> 6), lane = tid & 63, wr = wid >> 2, wc = wid & 3, fr = lane & 15, fq = lane >> 4;
    const int K = g.K, nt = K / BK;
    unsigned voffA[2], voffB[2];
#pragma unroll
    for (int i = 0; i < 2; ++i) { int R, C; stage_rc(tid * 16 + i * 8192, R, C); const int Rb = Epi::PERM ? ((R & ~31) + perm32(R & 31)) : R;
        voffA[i] = (unsigned)(R * K + C) * 2u; voffB[i] = (unsigned)(Rb * K + C) * 2u; }
    const size_t kstep = (size_t)(BK * 2);
    const size_t hstep = (size_t)HALF * K * 2;
    const size_t tstep = 2 * hstep;
    const unsigned ldsw = (unsigned)wid * 1024u;
    const int aoff = lds_byte(wr * 64 + fr, fq * 8), boff = lds_byte(wc * 32 + fr, fq * 8);
#define PG8_SA(b, h) (((b) * 2 + (h)) * HTB)
#define PG8_SB(b, h) ((4 + (b) * 2 + (h)) * HTB)
#define PG8_STAGE(bufoff, gbase, voff) do { _Pragma("unroll") for (int _i = 0; _i < 2; ++_i) \
        __builtin_amdgcn_global_load_lds((const unsigned*)((const char*)(gbase) + (voff)[_i]), (LAS unsigned*)(lds + (bufoff) + ldsw + _i * 8192), 16, 0, 0); } while (0)
#define PG8_LDA(dst, b, h) do { _Pragma("unroll") for (int m = 0; m < 4; ++m) _Pragma("unroll") for (int k = 0; k < 2; ++k) dst[m][k] = *(const LAS bf16x8*)(lds + PG8_SA(b, h) + aoff + m * 2048 + k * 1024); } while (0)
#define PG8_LDB(dst, b, h) do { _Pragma("unroll") for (int n = 0; n < 2; ++n) _Pragma("unroll") for (int k = 0; k < 2; ++k) dst[n][k] = *(const LAS bf16x8*)(lds + PG8_SB(b, h) + boff + n * 2048 + k * 1024); } while (0)
#define PG8_MMA(ai, bj, At, Bt) do { __builtin_amdgcn_s_setprio(1); _Pragma("unroll") for (int m = 0; m < 4; ++m) _Pragma("unroll") for (int n = 0; n < 2; ++n) _Pragma("unroll") for (int k = 0; k < 2; ++k) \
        acc[ai][bj][m][n] = __builtin_amdgcn_mfma_f32_16x16x32_bf16(Bt[n][k], At[m][k], acc[ai][bj][m][n], 0, 0, 0); __builtin_amdgcn_s_setprio(0); } while (0)
#define PG8_WAIT_V(n) asm volatile("s_waitcnt vmcnt(" #n ")" ::: "memory")
#define PG8_WAIT_L(n) asm volatile("s_waitcnt lgkmcnt(" #n ")" ::: "memory")
#define PG8_BAR __builtin_amdgcn_s_barrier()
#define PG8_SCHED __builtin_amdgcn_sched_barrier(0)
    Unit cur, nxt; int ui = 0;
    if (!S.next(0, cur)) return;
    f32x4 acc[2][2][4][2];
#pragma unroll
    for (int a = 0; a < 2; ++a)
#pragma unroll
        for (int b = 0; b < 2; ++b)
#pragma unroll
            for (int m = 0; m < 4; ++m)
#pragma unroll
                for (int n = 0; n < 2; ++n) acc[a][b][m][n] = (f32x4){0.f, 0.f, 0.f, 0.f};
    bf16x8 At[4][2], B0[2][2], B1[2][2];
    const char* cA = (const char*)g.A + (size_t)cur.pm * tstep; const char* cB = (const char*)g.Bt + (size_t)cur.pn * tstep;
    S.a_ready(cur);
    if constexpr (SP2) {
        PG8_STAGE(PG8_SB(0, 0), cB, voffB); PG8_STAGE(PG8_SB(0, 1), cB + hstep, voffB); PG8_STAGE(PG8_SA(0, 0), cA, voffA); PG8_STAGE(PG8_SA(0, 1), cA + hstep, voffA);
        if (wr == 1) PG8_BAR;
        PG8_WAIT_V(2); PG8_BAR;
        PG8_STAGE(PG8_SB(1, 0), cB + kstep, voffB); PG8_STAGE(PG8_SA(1, 0), cA + kstep, voffA); PG8_STAGE(PG8_SB(1, 1), cB + hstep + kstep, voffB);
        PG8_WAIT_V(6); PG8_BAR;
    } else {
        PG8_STAGE(PG8_SB(0, 0), cB, voffB); PG8_STAGE(PG8_SA(0, 0), cA, voffA); PG8_STAGE(PG8_SB(0, 1), cB + hstep, voffB); PG8_STAGE(PG8_SA(0, 1), cA + hstep, voffA);
        if (wr == 1) PG8_BAR;
        PG8_WAIT_V(4); PG8_BAR;
        PG8_STAGE(PG8_SB(1, 0), cB + kstep, voffB); PG8_STAGE(PG8_SA(1, 0), cA + kstep, voffA); PG8_STAGE(PG8_SB(1, 1), cB + hstep + kstep, voffB);
        PG8_WAIT_V(6); PG8_BAR;
    }
    for (;;) {
        const bool has_next = S.next(ui + 1, nxt);
        const char* nA = has_next ? (const char*)g.A + (size_t)nxt.pm * tstep : cA; const char* nB = has_next ? (const char*)g.Bt + (size_t)nxt.pn * tstep : cB;
        for (int t = 0; t < nt; t += 2) {
            const bool last = (t == nt - 2);
            const char* a1 = cA + (size_t)(t + 1) * kstep;
            const char* a2 = last ? nA : cA + (size_t)(t + 2) * kstep; const char* b2 = last ? nB : cB + (size_t)(t + 2) * kstep;
            const char* a3 = a2 + kstep; const char* b3 = b2 + kstep;
            if (last && has_next) S.a_ready(nxt);
            if constexpr (Epi::MIDK) { if (t == nt / 2) E.mid(acc, cur, wr, wc, fr, fq); }
            if constexpr (SP2) {
            PG8_LDB(B0, 0, 0); PG8_LDB(B1, 0, 1); PG8_SCHED; PG8_LDA(At, 0, 0); PG8_STAGE(PG8_SA(1, 1), a1 + hstep, voffA);
            PG8_WAIT_V(8); PG8_WAIT_L(0); PG8_BAR; PG8_MMA(0, 0, At, B0); PG8_MMA(0, 1, At, B1); PG8_BAR; PG8_SCHED;
            PG8_LDA(At, 0, 1); PG8_STAGE(PG8_SB(0, 0), b2, voffB); PG8_STAGE(PG8_SB(0, 1), b2 + hstep, voffB); PG8_STAGE(PG8_SA(0, 0), a2, voffA);
            PG8_WAIT_V(8); PG8_WAIT_L(0); PG8_BAR; PG8_MMA(1, 0, At, B0); PG8_MMA(1, 1, At, B1); PG8_BAR; PG8_SCHED;
            PG8_LDB(B0, 1, 0); PG8_LDB(B1, 1, 1); PG8_SCHED; PG8_LDA(At, 1, 0); PG8_STAGE(PG8_SA(0, 1), a2 + hstep, voffA);
            PG8_WAIT_V(8); PG8_WAIT_L(0); PG8_BAR; PG8_MMA(0, 0, At, B0); PG8_MMA(0, 1, At, B1); PG8_BAR; PG8_SCHED;
            PG8_LDA(At, 1, 1); PG8_STAGE(PG8_SB(1, 0), b3, voffB); PG8_STAGE(PG8_SB(1, 1), b3 + hstep, voffB); PG8_STAGE(PG8_SA(1, 0), a3, voffA);
            PG8_WAIT_V(8); PG8_WAIT_L(0); PG8_BAR; PG8_MMA(1, 0, At, B0); PG8_MMA(1, 1, At, B1); PG8_BAR; PG8_SCHED;
            } else {
            PG8_LDB(B0, 0, 0); PG8_SCHED; PG8_LDA(At, 0, 0); PG8_STAGE(PG8_SA(1, 1), a1 + hstep, voffA);
            PG8_WAIT_L(8); PG8_BAR; PG8_WAIT_L(0); PG8_MMA(0, 0, At, B0); PG8_BAR; PG8_SCHED;
            PG8_LDB(B1, 0, 1); PG8_STAGE(PG8_SB(0, 0), b2, voffB);
            PG8_BAR; PG8_WAIT_L(0); PG8_MMA(0, 1, At, B1); PG8_BAR;
            PG8_LDA(At, 0, 1); PG8_STAGE(PG8_SA(0, 0), a2, voffA);
            PG8_BAR; PG8_WAIT_L(0); PG8_MMA(1, 0, At, B0); PG8_BAR; PG8_SCHED;
            PG8_STAGE(PG8_SB(0, 1), b2 + hstep, voffB);
            PG8_WAIT_V(6); PG8_BAR; PG8_MMA(1, 1, At, B1); PG8_BAR;
            PG8_LDB(B0, 1, 0); PG8_SCHED; PG8_LDA(At, 1, 0); PG8_STAGE(PG8_SA(0, 1), a2 + hstep, voffA);
            PG8_WAIT_L(8); PG8_BAR; PG8_WAIT_L(0); PG8_MMA(0, 0, At, B0); PG8_BAR; PG8_SCHED;
            PG8_LDB(B1, 1, 1); PG8_STAGE(PG8_SB(1, 0), b3, voffB);
            PG8_BAR; PG8_WAIT_L(0); PG8_MMA(0, 1, At, B1); PG8_BAR;
            PG8_LDA(At, 1, 1); PG8_STAGE(PG8_SA(1, 0), a3, voffA);
            PG8_BAR; PG8_WAIT_L(0); PG8_MMA(1, 0, At, B0); PG8_BAR; PG8_SCHED;
            PG8_STAGE(PG8_SB(1, 1), b3 + hstep, voffB);
            PG8_WAIT_V(6); PG8_BAR; PG8_MMA(1, 1, At, B1); PG8_BAR;
            }
        }
        if constexpr (ALIGN_EPI) { if (wr == 0) PG8_BAR; }
        E(acc, cur, wr, wc, fr, fq); S.done(cur);
        if (!has_next) break;
#pragma unroll
        for (int a = 0; a < 2; ++a)
#pragma unroll
            for (int b = 0; b < 2; ++b)
#pragma unroll
                for (int m = 0; m < 4; ++m)
#pragma unroll
                    for (int n = 0; n < 2; ++n) acc[a][b][m][n] = (f32x4){0.f, 0.f, 0.f, 0.f};
        cur = nxt; cA = nA; cB = nB; ++ui;
        if constexpr (ALIGN_EPI) { if (wr == 1) PG8_BAR; }
    }
    PG8_WAIT_V(0);
    if constexpr (!ALIGN_EPI) { if (wr == 0) PG8_BAR; }
    PG8_BAR;
#undef PG8_SA
#undef PG8_SB
#undef PG8_STAGE
#undef PG8_LDA
#undef PG8_LDB
#undef PG8_MMA
#undef PG8_WAIT_V
#undef PG8_WAIT_L
#undef PG8_BAR
#undef PG8_SCHED
}
}
using pg8::Unit;

typedef f32x4 AccT[2][2][4][2];

struct EpiProj {
    static constexpr bool PERM = true, MIDK = false;
    bf16_t* O; const float* rot; const float* oml; int Lmask;
    DI void operator()(const AccT& acc, const Unit& u, int wr, int wc, int fr, int fq) const {
        const int pn = u.pn;
        const int row0 = u.pm * 256 + wr * 64 + fr;
        size_t base[2]; int rp;
#pragma unroll
        for (int bj = 0; bj < 2; ++bj) {
            if (pn < 8) { rp = 64; base[bj] = pj_ret(pn >> 1, (pn & 1) * 4 + bj * 2 + (wc >> 1)) + (wc & 1) * 32 + 8 * fq; }
            else if (pn < 18) { rp = 128; base[bj] = pj_hg((pn - 8) >> 1, (pn & 1) * 2 + bj) + wc * 32 + 8 * fq; }
            else { rp = 2048; base[bj] = PJ_G0 + (size_t)(Lmask >> 11) * MH * 2048 + (size_t)((pn - 18) * 256 + bj * 128 + wc * 32 + 8 * fq); }
        }
        int mode;
        if (pn < 4) mode = 4; else if (pn < 6) mode = 0; else if (pn < 10) mode = 1; else if (pn < 14) mode = 3; else if (pn < 16) mode = 0; else if (pn < 18) mode = 1; else mode = 2;
        if (mode == 4) {
            const float sc = pn < 2 ? 1.f : 0.125f;
            const int fi = 16 * (wc & 1) + 4 * fq;
#pragma unroll
            for (int ai = 0; ai < 2; ++ai)
#pragma unroll
                for (int m = 0; m < 4; ++m) {
                    const int row = row0 + ai * 128 + m * 16; const int pos = row & Lmask;
                    const f32x4 cs = *(const f32x4*)(rot + pos * 32 + fi) * sc, sn = *(const f32x4*)(rot + 4096 * 32 + pos * 32 + fi) * sc;
#pragma unroll
                    for (int bj = 0; bj < 2; ++bj) {
                        const f32x4 x1 = acc[ai][bj][m][0], x2 = acc[ai][bj][m][1];
                        const f32x4 o1 = x1 * cs - x2 * sn, o2 = x1 * sn + x2 * cs;
                        *(u32x4*)(O + base[bj] + (size_t)row * rp) = pack8(o1, o2);
                    }
                }
        } else if (mode == 0) {
#pragma unroll
            for (int ai = 0; ai < 2; ++ai)
#pragma unroll
                for (int m = 0; m < 4; ++m) {
                    const size_t row = (size_t)(row0 + ai * 128 + m * 16);
#pragma unroll
                    for (int bj = 0; bj < 2; ++bj) *(u32x4*)(O + base[bj] + row * rp) = pack8(acc[ai][bj][m][0], acc[ai][bj][m][1]);
                }
        } else if (mode == 2) {
#pragma unroll
            for (int ai = 0; ai < 2; ++ai)
#pragma unroll
                for (int m = 0; m < 4; ++m) {
                    const size_t row = (size_t)(row0 + ai * 128 + m * 16);
#pragma unroll
                    for (int bj = 0; bj < 2; ++bj)
                        *(u32x4*)(O + base[bj] + row * rp) = pack8(sig4_exp2(acc[ai][bj][m][0] * -1.4426950408889634f), sig4_exp2(acc[ai][bj][m][1] * -1.4426950408889634f));
                }
        } else {
            f32x4 om[2][2];
#pragma unroll
            for (int bj = 0; bj < 2; ++bj)
#pragma unroll
                for (int n = 0; n < 2; ++n) om[bj][n] = (f32x4){1.f, 1.f, 1.f, 1.f};
            if (mode == 3) {
                const float* op = oml + (pn >= 12 ? 512 : 0) + (pn & 1) * 256 + wc * 32 + 8 * fq;
#pragma unroll
                for (int bj = 0; bj < 2; ++bj)
#pragma unroll
                    for (int n = 0; n < 2; ++n) om[bj][n] = *(const f32x4*)(op + bj * 128 + 4 * n);
            }
            const float sgn = (mode == 3) ? 1.4426950408889634f : -1.4426950408889634f;
#pragma unroll
            for (int ai = 0; ai < 2; ++ai)
#pragma unroll
                for (int m = 0; m < 4; ++m) {
                    const size_t row = (size_t)(row0 + ai * 128 + m * 16);
#pragma unroll
                    for (int bj = 0; bj < 2; ++bj) {
                        f32x4 y[2];
#pragma unroll
                        for (int n = 0; n < 2; ++n) {
                            const f32x4 x = acc[ai][bj][m][n];
                            const f32x4 sg = sig4_exp2(x * sgn);
                            y[n] = ((mode == 1) ? x : om[bj][n]) * sg;
                        }
                        *(u32x4*)(O + base[bj] + row * rp) = pack8(y[0], y[1]);
                    }
                }
        }
    }
};

struct EpiRes {
    static constexpr bool PERM = true, MIDK = false;
    const float* base0; const float* base1; float* out; bf16_t* a2; float* ss;
    DI void operator()(const AccT& acc, const Unit& u, int wr, int wc, int fr, int fq) const {
        const int row0 = u.pm * 256 + wr * 64 + fr, col0 = u.pn * 256 + wc * 32 + 8 * fq;
        const float* base = u.pm < MH / 256 ? base0 : base1 - (size_t)MH * D;
#pragma unroll
        for (int ai = 0; ai < 2; ++ai)
#pragma unroll
            for (int m = 0; m < 4; ++m) {
                const size_t row = (size_t)(row0 + ai * 128 + m * 16);
                float s = 0.f;
#pragma unroll
                for (int bj = 0; bj < 2; ++bj) {
                    const float* bp = base + row * D + col0 + bj * 128;
                    const f32x4 h0 = *(const f32x4*)bp + acc[ai][bj][m][0], h1 = *(const f32x4*)(bp + 4) + acc[ai][bj][m][1];
                    float* op = out + row * D + col0 + bj * 128;
                    *(f32x4*)op = h0; *(f32x4*)(op + 4) = h1;
                    if (a2) *(u32x4*)(a2 + row * D + col0 + bj * 128) = pack8(h0, h1);
                    s += (h0[0] * h0[0] + h0[1] * h0[1]) + (h0[2] * h0[2] + h0[3] * h0[3]) + (h1[0] * h1[0] + h1[1] * h1[1]) + (h1[2] * h1[2] + h1[3] * h1[3]);
                }
                s += __shfl_xor(s, 16); s += __shfl_xor(s, 32);
                if (fq == 0) ss[row * 16 + u.pn * 4 + wc] = s;
            }
    }
};

template <int CTRL> DI float dpp_mov(float x) { return __builtin_bit_cast(float, __builtin_amdgcn_update_dpp(0, __builtin_bit_cast(int, x), CTRL, 0xf, 0xf, false)); }
template <int CTRL> DI f32x4 dpp4(const f32x4 x) { return (f32x4){dpp_mov<CTRL>(x[0]), dpp_mov<CTRL>(x[1]), dpp_mov<CTRL>(x[2]), dpp_mov<CTRL>(x[3])}; }
template <int CTRL> DI float dpp_movo(float old, float x) { return __builtin_bit_cast(float, __builtin_amdgcn_update_dpp(__builtin_bit_cast(int, old), __builtin_bit_cast(int, x), CTRL, 0xf, 0xf, false)); }
template <int CTRL> DI f32x4 dpp4o(const f32x4 o, const f32x4 x) { return (f32x4){dpp_movo<CTRL>(o[0], x[0]), dpp_movo<CTRL>(o[1], x[1]), dpp_movo<CTRL>(o[2], x[2]), dpp_movo<CTRL>(o[3], x[3])}; }
DI float gelu_tanh(float x) { const float z = 1.5957691216057308f * (x + 0.044715f * x * x * x); return x * sigm(z); }
DI f32x4 gelu_tanh4(f32x4 x) { const f32x4 t = (x + (x * x * x) * 0.044715f) * (-1.5957691216057308f * 1.4426950408889634f); return x * sig4_exp2(t); }
struct EpiFfn {
    static constexpr bool PERM = true, MIDK = false;
    const float* ss; const float* cw; const float* cb; bf16_t* G; float* SIDE; LAS float* HAL;
    DI void operator()(AccT& acc, const Unit& u, int wr, int wc, int fr, int fq) const {
        const int row0 = u.pm * 256 + wr * 64 + fr, c0 = wc * 32 + 8 * fq, f0 = u.pn * 128 + c0;
        LAS float* RSL = HAL + 1024;
        { const int t = opaque(threadIdx.x);
          if (t < 256) { const f32x4* sp = (const f32x4*)(ss + (size_t)(u.pm * 256 + t) * 16); const f32x4 s4 = (sp[0] + sp[1]) + (sp[2] + sp[3]);
                         RSL[t] = rsqrtf(((s4[0] + s4[1]) + (s4[2] + s4[3])) * (1.f / D) + EPS); } }
        asm volatile("s_waitcnt lgkmcnt(0)" ::: "memory"); __builtin_amdgcn_s_barrier(); asm volatile("" ::: "memory");
#pragma unroll
        for (int ai = 0; ai < 2; ++ai)
#pragma unroll
            for (int m = 0; m < 4; ++m) {
                const float rs = RSL[ai * 128 + wr * 64 + m * 16 + fr];
#pragma unroll
                for (int bj = 0; bj < 2; ++bj)
#pragma unroll
                    for (int n = 0; n < 2; ++n) acc[ai][bj][m][n] = acc[ai][bj][m][n] * rs;
            }
#pragma unroll
        for (int ai = 0; ai < 2; ++ai) {
            const int b = 2 * ai + wr;
            if (fr == 0) { *(LAS f32x4*)(HAL + (b * 2 + 0) * 128 + c0) = acc[ai][0][0][0]; *(LAS f32x4*)(HAL + (b * 2 + 0) * 128 + c0 + 4) = acc[ai][0][0][1]; }
            if (fr == 15) { *(LAS f32x4*)(HAL + (b * 2 + 1) * 128 + c0) = acc[ai][0][3][0]; *(LAS f32x4*)(HAL + (b * 2 + 1) * 128 + c0 + 4) = acc[ai][0][3][1]; }
        }
        asm volatile("s_waitcnt lgkmcnt(0)" ::: "memory"); __builtin_amdgcn_s_barrier(); asm volatile("" ::: "memory");
        f32x4 w0[2], w1[2], w2[2], bb[2];
#pragma unroll
        for (int n = 0; n < 2; ++n) { w0[n] = *(const f32x4*)(cw + f0 + 4 * n); w1[n] = *(const f32x4*)(cw + DFF + f0 + 4 * n); w2[n] = *(const f32x4*)(cw + 2 * DFF + f0 + 4 * n); bb[n] = *(const f32x4*)(cb + f0 + 4 * n); }
        const f32x4 zero4 = (f32x4){0.f, 0.f, 0.f, 0.f};
#pragma unroll
        for (int ai = 0; ai < 2; ++ai) {
            const int b = 2 * ai + wr;
            f32x4 ht[2], hb[2];
#pragma unroll
            for (int n = 0; n < 2; ++n) {
                ht[n] = b > 0 ? *(const LAS f32x4*)(HAL + ((b - 1) * 2 + 1) * 128 + c0 + 4 * n) : zero4;
                hb[n] = b < 3 ? *(const LAS f32x4*)(HAL + ((b + 1) * 2 + 0) * 128 + c0 + 4 * n) : zero4;
            }
#pragma unroll
            for (int m = 0; m < 4; ++m) {
                const size_t row = (size_t)(row0 + ai * 128 + m * 16);
                f32x4 x[2], y[2];
#pragma unroll
                for (int n = 0; n < 2; ++n) {
                    const f32x4 cur = acc[ai][0][m][n];
                    f32x4 altp, altn;
                    if (m > 0) altp = dpp4<0x121>(acc[ai][0][m > 0 ? m - 1 : 0][n]); else altp = ht[n];
                    if (m < 3) altn = dpp4<0x12F>(acc[ai][0][m < 3 ? m + 1 : 3][n]); else altn = hb[n];
                    const f32x4 up = dpp4o<0x111>(altp, cur), un = dpp4o<0x101>(altn, cur);
                    x[n] = bb[n] + w0[n] * up + w1[n] * cur + w2[n] * un;
                    y[n] = gelu_tanh4(x[n]) * acc[ai][1][m][n];
                }
                *(u32x4*)(G + row * DFF + f0) = pack8(y[0], y[1]);
                if (m == 0 && b == 0 && fr == 0) {
                    float* sd = SIDE + ((size_t)(u.pm * 2 + 0) * 3) * DFF + f0;
#pragma unroll
                    for (int n = 0; n < 2; ++n) { *(f32x4*)(sd + 4 * n) = x[n]; *(f32x4*)(sd + DFF + 4 * n) = acc[ai][0][m][n]; *(f32x4*)(sd + 2 * DFF + 4 * n) = acc[ai][1][m][n]; }
                }
                if (m == 3 && b == 3 && fr == 15) {
                    float* sd = SIDE + ((size_t)(u.pm * 2 + 1) * 3) * DFF + f0;
#pragma unroll
                    for (int n = 0; n < 2; ++n) { *(f32x4*)(sd + 4 * n) = x[n]; *(f32x4*)(sd + DFF + 4 * n) = acc[ai][0][m][n]; *(f32x4*)(sd + 2 * DFF + 4 * n) = acc[ai][1][m][n]; }
                }
            }
        }
    }
};
DI void ffn_fixup_phase(const float* __restrict__ SIDE, const float* __restrict__ cw, bf16_t* __restrict__ G, int gtid, int NT) {
    constexpr int NCH = DFF / 8;
    for (int idx = gtid; idx < (2 * MH / 256) * 2 * NCH; idx += NT) {
        const int ci = idx % NCH, pw = idx / NCH, which = pw & 1, pm = pw >> 1, f0 = 8 * ci;
        const int row = 256 * pm + (which ? 255 : 0), L = row < MH ? 2048 : 4096, pos = row & (L - 1);
        const float* sd = SIDE + ((size_t)(pm * 2 + which) * 3) * DFF + f0;
        const bool has = which ? (pos != L - 1) : (pos != 0);
        const float* nb = SIDE + ((size_t)((which ? pm + 1 : pm - 1) * 2 + (which ? 0 : 1)) * 3 + 1) * DFF + f0;
        const float* wg = cw + (which ? 2 * DFF : 0) + f0;
        f32x4 y[2];
#pragma unroll
        for (int n = 0; n < 2; ++n) {
            f32x4 x = *(const f32x4*)(sd + 4 * n); const f32x4 vv = *(const f32x4*)(sd + 2 * DFF + 4 * n);
            if (has) x = x + *(const f32x4*)(wg + 4 * n) * *(const f32x4*)(nb + 4 * n);
#pragma unroll
            for (int j = 0; j < 4; ++j) y[n][j] = gelu_tanh(x[j]) * vv[j];
        }
        *(u32x4*)(G + (size_t)row * DFF + f0) = pack8(y[0], y[1]);
    }
}


struct EpiFinal {
    static constexpr bool PERM = true, MIDK = false;
    const float* base; float* out; const float* wfin; float* xs; unsigned* cnt; LAS unsigned char* lx;
    DI void operator()(AccT& acc, const Unit& u, int wr, int wc, int fr, int fq) const {
        LAS float* PT = (LAS float*)lx; LAS float* ST = (LAS float*)(lx + 4096); volatile LAS unsigned* FL = (volatile LAS unsigned*)(lx + 4096 + 1024);
        const int row0 = u.pm * 256 + wr * 64 + fr, col0 = u.pn * 256 + wc * 32 + 8 * fq;
        const int tid = opaque(threadIdx.x), lane = tid & 63, wid = __builtin_amdgcn_readfirstlane(tid >> 6);
#pragma unroll
        for (int ai = 0; ai < 2; ++ai)
#pragma unroll
            for (int m = 0; m < 4; ++m) {
                const size_t row = (size_t)(row0 + ai * 128 + m * 16);
                float s = 0.f;
#pragma unroll
                for (int bj = 0; bj < 2; ++bj) {
                    const float* bp = base + row * D + col0 + bj * 128;
                    const f32x4 h0 = *(const f32x4*)bp + acc[ai][bj][m][0], h1 = *(const f32x4*)(bp + 4) + acc[ai][bj][m][1];
                    acc[ai][bj][m][0] = h0; acc[ai][bj][m][1] = h1;
                    s += (h0[0] * h0[0] + h0[1] * h0[1]) + (h0[2] * h0[2] + h0[3] * h0[3]) + (h1[0] * h1[0] + h1[1] * h1[1]) + (h1[2] * h1[2] + h1[3] * h1[3]);
                }
                s += __shfl_xor(s, 16); s += __shfl_xor(s, 32);
                if (fq == 0) PT[(ai * 128 + wr * 64 + m * 16 + fr) * 4 + wc] = s;
            }
        asm volatile("s_waitcnt lgkmcnt(0)" ::: "memory"); __builtin_amdgcn_s_barrier(); asm volatile("" ::: "memory");
        const int prow = wid * 32 + (lane & 31);
        if (lane < 32) {
            const float tot = (PT[prow * 4 + 0] + PT[prow * 4 + 1]) + (PT[prow * 4 + 2] + PT[prow * 4 + 3]);
            __hip_atomic_store(xs + ((size_t)(u.pm * 256 + prow) * 4 + u.pn), tot, __ATOMIC_RELAXED, __HIP_MEMORY_SCOPE_AGENT);
        }
        asm volatile("s_waitcnt vmcnt(0)" ::: "memory");
        if (lane == 0) __hip_atomic_fetch_add(cnt + 64 * u.pm, 1u, __ATOMIC_RELAXED, __HIP_MEMORY_SCOPE_AGENT);
        if (wid == 0) {
            unsigned spins = 0;
            for (;;) {
                if ((unsigned)__builtin_amdgcn_readfirstlane(__hip_atomic_load(cnt + 64 * u.pm, __ATOMIC_RELAXED, __HIP_MEMORY_SCOPE_AGENT)) >= 32u) break;
                if (++spins > (1u << 22)) break;
                __builtin_amdgcn_s_sleep(2);
            }
            __builtin_amdgcn_fence(__ATOMIC_ACQUIRE, "agent");
            if (lane == 0) FL[0] = 1u;
        }
        asm volatile("s_waitcnt vmcnt(0) lgkmcnt(0)" ::: "memory"); __builtin_amdgcn_s_barrier(); asm volatile("" ::: "memory");
        if (lane < 32) {
            const float* sl = xs + (size_t)(u.pm * 256 + prow) * 4;
            const float t0 = __hip_atomic_load(sl + 0, __ATOMIC_RELAXED, __HIP_MEMORY_SCOPE_AGENT), t1 = __hip_atomic_load(sl + 1, __ATOMIC_RELAXED, __HIP_MEMORY_SCOPE_AGENT);
            const float t2 = __hip_atomic_load(sl + 2, __ATOMIC_RELAXED, __HIP_MEMORY_SCOPE_AGENT), t3 = __hip_atomic_load(sl + 3, __ATOMIC_RELAXED, __HIP_MEMORY_SCOPE_AGENT);
            ST[prow] = rsqrtf(((t0 + t1) + (t2 + t3)) * (1.f / D) + EPS);
        }
        asm volatile("s_waitcnt vmcnt(0) lgkmcnt(0)" ::: "memory"); __builtin_amdgcn_s_barrier(); asm volatile("" ::: "memory");
        f32x4 wv[2][2];
#pragma unroll
        for (int bj = 0; bj < 2; ++bj)
#pragma unroll
            for (int n = 0; n < 2; ++n) wv[bj][n] = *(const f32x4*)(wfin + col0 + bj * 128 + 4 * n);
#pragma unroll
        for (int ai = 0; ai < 2; ++ai)
#pragma unroll
            for (int m = 0; m < 4; ++m) {
                const int rl = ai * 128 + wr * 64 + m * 16 + fr; const float rs = ST[rl];
                float* op = out + (size_t)(u.pm * 256 + rl) * D + col0;
#pragma unroll
                for (int bj = 0; bj < 2; ++bj) { *(f32x4*)(op + bj * 128) = acc[ai][bj][m][0] * rs * wv[bj][0]; *(f32x4*)(op + bj * 128 + 4) = acc[ai][bj][m][1] * rs * wv[bj][1]; }
            }
    }
};


struct EpiMerge2 {
    static constexpr bool PERM = true, MIDK = true;
    const bf16_t* GT; bf16_t* MG;
    DI void mid(AccT& acc, const Unit& u, int wr, int wc, int fr, int fq) const {
        fr = opaque(fr); fq = opaque(fq);
        const int row0 = u.pm * 256 + wr * 64 + fr, col0 = u.pn * 256 + wc * 32 + 8 * fq;
#pragma unroll
        for (int ai = 0; ai < 2; ++ai)
#pragma unroll
            for (int m = 0; m < 4; ++m) {
                const size_t row = (size_t)(row0 + ai * 128 + m * 16);
#pragma unroll
                for (int bj = 0; bj < 2; ++bj) {
                    f32x4 a0, a1, b0, b1;
                    unpack8(*(const u32x4*)(GT + row * 2048 + col0 + bj * 128), a0, a1);
                    unpack8(*(const u32x4*)(GT + row * 2048 + 1024 + col0 + bj * 128), b0, b1);
#pragma unroll
                    for (int j = 0; j < 4; ++j) { a0[j] *= __builtin_amdgcn_rcpf(fmaxf(b0[j], 1e-30f)); a1[j] *= __builtin_amdgcn_rcpf(fmaxf(b1[j], 1e-30f)); }
                    acc[ai][bj][m][0] = acc[ai][bj][m][0] * a0; acc[ai][bj][m][1] = acc[ai][bj][m][1] * a1;
                }
                asm volatile("" ::: "memory");
            }
    }
    DI void operator()(const AccT& acc, const Unit& u, int wr, int wc, int fr, int fq) const {
        const int row0 = u.pm * 256 + wr * 64 + fr, col0 = u.pn * 256 + wc * 32 + 8 * fq;
#pragma unroll
        for (int ai = 0; ai < 2; ++ai)
#pragma unroll
            for (int m = 0; m < 4; ++m) {
                const size_t row = (size_t)(row0 + ai * 128 + m * 16);
#pragma unroll
                for (int bj = 0; bj < 2; ++bj) {
                    f32x4 b0, b1; unpack8(*(const u32x4*)(GT + row * 2048 + 1024 + col0 + bj * 128), b0, b1);
#pragma unroll
                    for (int j = 0; j < 4; ++j) { b0[j] = fmaxf(b0[j], 1e-30f); b1[j] = fmaxf(b1[j], 1e-30f); }
                    *(u32x4*)(MG + row * D + col0 + bj * 128) = pack8(acc[ai][bj][m][0] * b0, acc[ai][bj][m][1] * b1);
                }
            }
    }
};

template <int MAP> DI int src_col(int p) {
    if (MAP == 1) { if (p < 1024) { const int w = p & 63; const int d = 32 * ((w >> 2) & 1) + 16 * (w >> 5) + 4 * ((w >> 3) & 3) + (w & 3); return (p & ~63) + d; } return p; }
    if (MAP == 2) { const int j = p >> 8, hf = (p >> 7) & 1, c = p & 127; return hf * DFF + 128 * j + c; }
    return p;
}
template <int MAP> DI void p0_item(const float* __restrict__ W, int K, int Nsrc, bf16_t* __restrict__ WT, const float* __restrict__ ks, LAS float* scr, int item, int nblk, int lane, int ldw = 0, int koff = 0) {
    if (ldw == 0) ldw = K;
    const int kb = item / nblk, nb = item % nblk, k0 = 64 * kb, n0 = 32 * nb;
    const int sc = src_col<MAP>(n0 + (lane & 31));
#pragma unroll 8
    for (int i = 0; i < 32; ++i) { const int kk = 2 * i + (lane >> 5); float v = W[(size_t)(k0 + kk) * Nsrc + sc]; if (ks) v *= ks[k0 + kk]; scr[kk * 33 + (lane & 31)] = v; }
    asm volatile("s_waitcnt lgkmcnt(0)" ::: "memory");
    const int c = lane & 7;
#pragma unroll
    for (int j = 0; j < 4; ++j) { const int n = (lane >> 3) + 8 * j; const LAS float* s = scr + (8 * c) * 33 + n;
        u32x4 o; o.x = pk2(s[0 * 33], s[1 * 33]); o.y = pk2(s[2 * 33], s[3 * 33]); o.z = pk2(s[4 * 33], s[5 * 33]); o.w = pk2(s[6 * 33], s[7 * 33]);
        *(u32x4*)(WT + (size_t)(n0 + n) * ldw + koff + k0 + 8 * c) = o; }
    asm volatile("s_waitcnt lgkmcnt(0)" ::: "memory");
}
DI void rms_row_bf16(const float* __restrict__ xrow, const float* __restrict__ w, bf16_t* __restrict__ orow, int lane) {
    const f32x4* xr = (const f32x4*)xrow + lane; f32x4 v[4]; float s = 0.f;
#pragma unroll
    for (int j = 0; j < 4; ++j) { v[j] = xr[64 * j]; s += (v[j][0] * v[j][0] + v[j][1] * v[j][1]) + (v[j][2] * v[j][2] + v[j][3] * v[j][3]); }
    const float rs = rsqrtf(wave_sum(s) * (1.f / D) + EPS);
    u32x2* o8 = (u32x2*)orow + lane;
#pragma unroll
    for (int j = 0; j < 4; ++j) { const f32x4 wv = ((const f32x4*)w)[lane + 64 * j]; const f32x4 y = v[j] * rs * wv; u32x2 o; o.x = pk2(y[0], y[1]); o.y = pk2(y[2], y[3]); o8[64 * j] = o; }
}

constexpr int HGP = 136;
constexpr int RTP = 72;
typedef short s16x4 __attribute__((ext_vector_type(4)));
#ifndef MK_NO_TR
DI bf16x8 ld_tr(const LAS bf16_t* t, int pitch, int row0, int col, int lane) {
    const int r = lane & 15, qq = r >> 2, p = r & 3;
    LAS bf16_t* a = (LAS bf16_t*)t + (row0 + qq) * pitch + (col - r) + 4 * p;
    const s16x4 lo = __builtin_amdgcn_ds_read_tr16_b64_v4i16((LAS s16x4*)a);
    const s16x4 hi = __builtin_amdgcn_ds_read_tr16_b64_v4i16((LAS s16x4*)(a + 4 * pitch));
    return __builtin_shufflevector(lo, hi, 0, 1, 2, 3, 4, 5, 6, 7);
}
#else
DI bf16x8 ld_tr(const LAS bf16_t* t, int pitch, int row0, int col, int lane) {
    bf16x8 v;
#pragma unroll
    for (int e = 0; e < 8; ++e) v[e] = (short)t[(row0 + e) * pitch + col];
    return v;
}
#endif
DI bf16x8 ld_row(const LAS bf16_t* t, int pitch, int row, int col0) { return *(const LAS bf16x8*)(t + row * pitch + col0); }
DI void st4bf(LAS bf16_t* p, float a, float b, float c, float d) { u32x2 w; w.x = pk2(a, b); w.y = pk2(c, d); *(LAS u32x2*)p = w; }

DI void hg_gates(LAS bf16_t* KF, LAS bf16_t* KB, LAS bf16_t* QF, LAS bf16_t* QB, LAS float* SEG, const bool withq, int tid) {
    const int dir = tid >> 8, seg = __builtin_amdgcn_readfirstlane((tid >> 6) & 3), dp = tid & 63;
    LAS unsigned* Kt = (LAS unsigned*)(dir ? KB : KF); LAS unsigned* Qt = (LAS unsigned*)(dir ? QB : QF);
    constexpr int WP = HGP / 2;
    float p0 = 1.f, p1 = 1.f;
#pragma unroll
    for (int s = 0; s < 16; ++s) { const int t = dir ? (16 * seg + 15 - s) : (16 * seg + s); const unsigned w = Kt[t * WP + dp]; p0 *= 1.f - bflo(w); p1 *= 1.f - bfhi(w); }
    SEG[(dir * 4 + seg) * 128 + 2 * dp] = p0; SEG[(dir * 4 + seg) * 128 + 2 * dp + 1] = p1;
    __syncthreads();
    float P0 = 1.f, P1 = 1.f;
#pragma unroll
    for (int s2 = 0; s2 < 4; ++s2) { const bool before = dir ? (s2 > seg) : (s2 < seg); if (before) { P0 *= SEG[(dir * 4 + s2) * 128 + 2 * dp]; P1 *= SEG[(dir * 4 + s2) * 128 + 2 * dp + 1]; } }
#pragma unroll
    for (int s = 0; s < 16; ++s) {
        const int t = dir ? (16 * seg + 15 - s) : (16 * seg + s);
        const unsigned w = Kt[t * WP + dp]; const float k0 = bflo(w), k1 = bfhi(w);
        P0 *= 1.f - k0; P1 *= 1.f - k1;
        Kt[t * WP + dp] = pk2(k0 * __builtin_amdgcn_rcpf(fmaxf(P0, 1e-30f)), k1 * __builtin_amdgcn_rcpf(fmaxf(P1, 1e-30f)));
        if (withq) { const unsigned qw = Qt[t * WP + dp]; Qt[t * WP + dp] = pk2(bflo(qw) * P0, bfhi(qw) * P1); }
    }
    __syncthreads();
}
DI float hg_seg_total(const LAS float* SEG, int dir, int d) { return (SEG[(dir * 4 + 0) * 128 + d] * SEG[(dir * 4 + 1) * 128 + d]) * (SEG[(dir * 4 + 2) * 128 + d] * SEG[(dir * 4 + 3) * 128 + d]); }

DI void hgs_fetch(u32x4 (&R)[6], const bf16_t* __restrict__ PJ, int item, int tid) {
    const int h = item & 3; const size_t toff = (size_t)(item >> 2) * 64 * 128;
#pragma unroll
    for (int j = 0; j < 2; ++j) { const size_t o = toff + 8 * (size_t)(tid + NTHREADS * j);
        R[j] = *(const u32x4*)(PJ + pj_hg(1, h) + o); R[2 + j] = *(const u32x4*)(PJ + pj_hg(2, h) + o); R[4 + j] = *(const u32x4*)(PJ + pj_hg(3, h) + o); }
}
DI void hgo_fetch(u32x4 (&R)[8], const bf16_t* __restrict__ PJ, int item, int tid) {
    const int h = item & 3; const size_t toff = (size_t)(item >> 2) * 64 * 128;
#pragma unroll
    for (int j = 0; j < 2; ++j) { const size_t o = toff + 8 * (size_t)(tid + NTHREADS * j);
        R[j] = *(const u32x4*)(PJ + pj_hg(0, h) + o); R[2 + j] = *(const u32x4*)(PJ + pj_hg(1, h) + o); R[4 + j] = *(const u32x4*)(PJ + pj_hg(2, h) + o); R[6 + j] = *(const u32x4*)(PJ + pj_hg(3, h) + o); }
}
DI void rts_fetch(u32x4 (&R)[4], const bf16_t* __restrict__ PJ, int item, int tid) {
    const int h = item & 7; const size_t toff = (size_t)(item >> 3) * 128 * 64;
#pragma unroll
    for (int j = 0; j < 2; ++j) { const size_t o = toff + 8 * (size_t)(tid + NTHREADS * j);
        R[j] = *(const u32x4*)(PJ + pj_ret(1, h) + o); R[2 + j] = *(const u32x4*)(PJ + pj_ret(2, h) + o); }
}
DI void rto_fetch(u32x4 (&R)[6], const bf16_t* __restrict__ PJ, int item, int tid) {
    const int h = item & 7; const size_t toff = (size_t)(item >> 3) * 128 * 64;
#pragma unroll
    for (int j = 0; j < 2; ++j) { const size_t o = toff + 8 * (size_t)(tid + NTHREADS * j);
        R[j] = *(const u32x4*)(PJ + pj_ret(0, h) + o); R[2 + j] = *(const u32x4*)(PJ + pj_ret(1, h) + o); R[4 + j] = *(const u32x4*)(PJ + pj_ret(2, h) + o); }
}

DI void hg_state_item(LAS unsigned char* lds, const bf16_t* __restrict__ PJ, bf16_t* __restrict__ dS, float* __restrict__ HE, int item, int next, u32x4 (&R)[6], int tid, int lane, int wid) {
    LAS bf16_t* KF = (LAS bf16_t*)lds; LAS bf16_t* KB = KF + 64 * HGP; LAS bf16_t* V = KB + 64 * HGP; LAS float* SEG = (LAS float*)(V + 64 * HGP);
#pragma unroll
    for (int j = 0; j < 2; ++j) { const int i = tid + NTHREADS * j; const int off = (i >> 4) * HGP + 8 * (i & 15);
        *(LAS u32x4*)(KF + off) = R[j]; *(LAS u32x4*)(KB + off) = R[2 + j]; *(LAS u32x4*)(V + off) = R[4 + j]; }
    __syncthreads();
    if (next >= 0) hgs_fetch(R, PJ, next, tid);
    hg_gates(KF, KB, nullptr, nullptr, SEG, false, tid);
    if (tid < 256) { const int dr = tid >> 7, d = tid & 127; HE[((size_t)item * 2 + dr) * 128 + d] = hg_seg_total(SEG, dr, d); }
    const int dir = wid >> 2, wq = wid & 3, r = lane & 15, q = lane >> 4;
    const LAS bf16_t* Kt = dir ? KB : KF;
    f32x4 acc[2][8];
#pragma unroll
    for (int mt = 0; mt < 2; ++mt)
#pragma unroll
        for (int nt = 0; nt < 8; ++nt) acc[mt][nt] = (f32x4){0.f, 0.f, 0.f, 0.f};
#pragma unroll
    for (int ks = 0; ks < 2; ++ks) {
        bf16x8 A[2];
#pragma unroll
        for (int mt = 0; mt < 2; ++mt) A[mt] = ld_tr(Kt, HGP, 32 * ks + 8 * q, 32 * wq + 16 * mt + r, lane);
#pragma unroll
        for (int nt = 0; nt < 8; ++nt) { const bf16x8 B = ld_tr(V, HGP, 32 * ks + 8 * q, 16 * nt + r, lane);
#pragma unroll
            for (int mt = 0; mt < 2; ++mt) acc[mt][nt] = MFMA16(A[mt], B, acc[mt][nt]); }
    }
    LAS bf16_t* STG = (LAS bf16_t*)(lds + 57344);
#pragma unroll
    for (int mt = 0; mt < 2; ++mt) {
        const int dk0 = 32 * wq + 16 * mt + 4 * q; f32x4 e;
#pragma unroll
        for (int jj = 0; jj < 4; ++jj) e[jj] = hg_seg_total(SEG, dir, dk0 + jj);
#pragma unroll
        for (int nt = 0; nt < 8; ++nt) { const int dv = 16 * nt + r; const f32x4 v = acc[mt][nt] * e; st4bf(STG + (dir * 128 + dv) * HGP + dk0, v[0], v[1], v[2], v[3]); }
    }
    __syncthreads();
    {
        bf16_t* dst = dS + (size_t)item * 2 * 128 * 128;
#pragma unroll
        for (int k = 0; k < 8; ++k) { const int ch = tid + NTHREADS * k; const int rowi = ch >> 4, c16 = ch & 15;
            *(u32x4*)(dst + (size_t)rowi * 128 + 8 * c16) = *(const LAS u32x4*)(STG + rowi * HGP + 8 * c16); }
    }
    __syncthreads();
}

DI void hg_out_item(LAS unsigned char* lds, const bf16_t* __restrict__ PJ, const bf16_t* __restrict__ HST, const float* __restrict__ wn, bf16_t* __restrict__ HGO, int item, int next, u32x4 (&R)[8], int tid, int lane, int wid) {
    const int c = item >> 2, h = item & 3; const size_t t0 = (size_t)c * 64;
    LAS bf16_t* QF = (LAS bf16_t*)lds; LAS bf16_t* QB = QF + 64 * HGP; LAS bf16_t* KF = QB + 64 * HGP; LAS bf16_t* KB = KF + 64 * HGP; LAS bf16_t* V = KB + 64 * HGP;
    LAS bf16_t* PF = V + 64 * HGP; LAS bf16_t* PB = PF + 64 * RTP; LAS float* SEG = (LAS float*)(PB + 64 * RTP);
#pragma unroll
    for (int j = 0; j < 2; ++j) { const int i = tid + NTHREADS * j; const int off = (i >> 4) * HGP + 8 * (i & 15);
        *(LAS u32x4*)(QF + off) = R[j]; *(LAS u32x4*)(QB + off) = R[j]; *(LAS u32x4*)(KF + off) = R[2 + j]; *(LAS u32x4*)(KB + off) = R[4 + j]; *(LAS u32x4*)(V + off) = R[6 + j]; }
    __syncthreads();
    if (next >= 0) hgo_fetch(R, PJ, next, tid);
    const int dir = wid >> 2, w4 = wid & 3, r = lane & 15, q = lane >> 4;
    bf16x8 SB[2][4];
#pragma unroll
    for (int dr = 0; dr < 2; ++dr) { const bf16_t* st = HST + ((size_t)item * 2 + dr) * 128 * 128;
#pragma unroll
      for (int ks = 0; ks < 4; ++ks) SB[dr][ks] = *(const bf16x8*)(st + (size_t)(16 * wid + r) * 128 + 32 * ks + 8 * q); }
    hg_gates(KF, KB, QF, QB, SEG, true, tid);
    const LAS bf16_t* Kt = dir ? KB : KF; const LAS bf16_t* Qt = dir ? QB : QF; LAS bf16_t* Pt = dir ? PB : PF;
    {
        f32x4 sc[4];
#pragma unroll
        for (int it = 0; it < 4; ++it) sc[it] = (f32x4){0.f, 0.f, 0.f, 0.f};
#pragma unroll
        for (int ks = 0; ks < 4; ++ks) { const bf16x8 A = ld_row(Kt, HGP, 16 * w4 + r, 32 * ks + 8 * q);
#pragma unroll
            for (int it = 0; it < 4; ++it) { const bf16x8 B = ld_row(Qt, HGP, 16 * it + r, 32 * ks + 8 * q); sc[it] = MFMA16(A, B, sc[it]); } }
#pragma unroll
        for (int it = 0; it < 4; ++it) { const int i = 16 * it + r; float v[4];
#pragma unroll
            for (int jj = 0; jj < 4; ++jj) { const int j = 16 * w4 + 4 * q + jj; const bool keep = dir ? (j >= i) : (j <= i); v[jj] = keep ? sc[it][jj] : 0.f; }
            st4bf(Pt + i * RTP + 16 * w4 + 4 * q, v[0], v[1], v[2], v[3]); }
    }
    __syncthreads();
    f32x4 o[4];
#pragma unroll
    for (int it = 0; it < 4; ++it) o[it] = (f32x4){0.f, 0.f, 0.f, 0.f};
#pragma unroll
    for (int ks = 0; ks < 2; ++ks) {
        const bf16x8 B = ld_tr(V, HGP, 32 * ks + 8 * q, 16 * wid + r, lane);
#pragma unroll
        for (int it = 0; it < 4; ++it) { const bf16x8 Af = ld_row(PF, RTP, 16 * it + r, 32 * ks + 8 * q), Ab = ld_row(PB, RTP, 16 * it + r, 32 * ks + 8 * q);
            o[it] = MFMA16(Af, B, o[it]); o[it] = MFMA16(Ab, B, o[it]); }
    }
#pragma unroll
    for (int dr = 0; dr < 2; ++dr) { const LAS bf16_t* Qd = dr ? QB : QF;
#pragma unroll
        for (int ks = 0; ks < 4; ++ks) {
#pragma unroll
            for (int it = 0; it < 4; ++it) { const bf16x8 A = ld_row(Qd, HGP, 16 * it + r, 32 * ks + 8 * q); o[it] = MFMA16(A, SB[dr][ks], o[it]); } } }
    const int fi = tid >> 3, fcc = tid & 7;
    const bf16_t* gp = PJ + pj_hg(4, h) + (t0 + fi) * 128 + 16 * fcc;
    const u32x4 gw0 = *(const u32x4*)gp, gw1 = *(const u32x4*)(gp + 8);
    __syncthreads();
    LAS float* OX = (LAS float*)lds;
#pragma unroll
    for (int it = 0; it < 4; ++it)
#pragma unroll
        for (int jj = 0; jj < 4; ++jj) OX[(16 * it + 4 * q + jj) * 132 + 16 * wid + r] = o[it][jj];
    __syncthreads();
    {
        const LAS f32x4* op = (const LAS f32x4*)(OX + fi * 132 + 16 * fcc);
        f32x4 v[4]; float ss = 0.f;
#pragma unroll
        for (int k = 0; k < 4; ++k) { v[k] = op[k]; ss += (v[k][0] * v[k][0] + v[k][1] * v[k][1]) + (v[k][2] * v[k][2] + v[k][3] * v[k][3]); }
        ss += __shfl_xor(ss, 1); ss += __shfl_xor(ss, 2); ss += __shfl_xor(ss, 4);
        const float rs = rsqrtf(ss * (1.f / 128.f) + EPS);
        const float* wp = wn + 128 * h + 16 * fcc;
        bf16_t* outp = HGO + (t0 + fi) * 1024 + 512 + 128 * h + 16 * fcc;
#pragma unroll
        for (int hh = 0; hh < 2; ++hh) {
            f32x4 g0, g1; unpack8(hh ? gw1 : gw0, g0, g1);
            const f32x4 w0 = *(const f32x4*)(wp + 8 * hh), w1 = *(const f32x4*)(wp + 8 * hh + 4);
            *(u32x4*)(outp + 8 * hh) = pack8(v[2 * hh] * rs * w0 * g0, v[2 * hh + 1] * rs * w1 * g1);
        }
    }
    __syncthreads();
}

DI void ret_state_item(LAS unsigned char* lds, const bf16_t* __restrict__ PJ, bf16_t* __restrict__ RS, int item, int next, u32x4 (&R)[4], int tid, int lane, int wid) {
    const int h = item & 7; const float lg = lg2gamma(h);
    LAS bf16_t* KF = (LAS bf16_t*)lds; LAS bf16_t* KB = KF + 128 * RTP; LAS bf16_t* V = KB + 128 * RTP;
#pragma unroll
    for (int j = 0; j < 2; ++j) { const int i = tid + NTHREADS * j; const int row = i >> 3, ch = i & 7;
        f32x4 a, b; unpack8(R[j], a, b);
        const float wf = __builtin_amdgcn_exp2f((float)(127 - row) * lg), wb = __builtin_amdgcn_exp2f((float)row * lg);
        *(LAS u32x4*)(KF + row * RTP + 8 * ch) = pack8(a * wf, b * wf); *(LAS u32x4*)(KB + row * RTP + 8 * ch) = pack8(a * wb, b * wb);
        *(LAS u32x4*)(V + row * RTP + 8 * ch) = R[2 + j]; }
    __syncthreads();
    if (next >= 0) rts_fetch(R, PJ, next, tid);
    const int dkt = wid & 3, dvh = wid >> 2, r = lane & 15, q = lane >> 4;
    f32x4 acc[2][2];
#pragma unroll
    for (int a = 0; a < 2; ++a)
#pragma unroll
        for (int b = 0; b < 2; ++b) acc[a][b] = (f32x4){0.f, 0.f, 0.f, 0.f};
#pragma unroll
    for (int ks = 0; ks < 4; ++ks) {
        const bf16x8 Af = ld_tr(KF, RTP, 32 * ks + 8 * q, 16 * dkt + r, lane), Ab = ld_tr(KB, RTP, 32 * ks + 8 * q, 16 * dkt + r, lane);
#pragma unroll
        for (int nt = 0; nt < 2; ++nt) { const bf16x8 B = ld_tr(V, RTP, 32 * ks + 8 * q, 32 * dvh + 16 * nt + r, lane);
            acc[0][nt] = MFMA16(Af, B, acc[0][nt]); acc[1][nt] = MFMA16(Ab, B, acc[1][nt]); }
    }
#pragma unroll
    for (int dr = 0; dr < 2; ++dr)
#pragma unroll
        for (int nt = 0; nt < 2; ++nt) { const int dv = 32 * dvh + 16 * nt + r, dk0 = 16 * dkt + 4 * q; const f32x4 v = acc[dr][nt]; u32x2 w; w.x = pk2(v[0], v[1]); w.y = pk2(v[2], v[3]);
            *(u32x2*)(RS + (((size_t)item * 2 + dr) * 64 + dv) * 64 + dk0) = w; }
    __syncthreads();
}

DI void ret_out_item(LAS unsigned char* lds, const bf16_t* __restrict__ PJ, const bf16_t* __restrict__ RST, const float* __restrict__ wn, bf16_t* __restrict__ RET, int item, int next, u32x4 (&R)[6], int tid, int lane, int wid) {
    const int c = item >> 3, h = item & 7; const size_t t0 = (size_t)c * 128; const float lg = lg2gamma(h);
    LAS bf16_t* Q = (LAS bf16_t*)lds; LAS bf16_t* QF = Q + 128 * RTP; LAS bf16_t* QB = QF + 128 * RTP; LAS bf16_t* K = QB + 128 * RTP; LAS bf16_t* V = K + 128 * RTP; LAS bf16_t* P = V + 128 * RTP;
#pragma unroll
    for (int j = 0; j < 2; ++j) { const int i = tid + NTHREADS * j; const int row = i >> 3, ch = i & 7;
        f32x4 a, b; unpack8(R[j], a, b);
        const float wf = __builtin_amdgcn_exp2f((float)(row + 1) * lg), wb = __builtin_amdgcn_exp2f((float)(128 - row) * lg);
        *(LAS u32x4*)(Q + row * RTP + 8 * ch) = R[j];
        *(LAS u32x4*)(QF + row * RTP + 8 * ch) = pack8(a * wf, b * wf); *(LAS u32x4*)(QB + row * RTP + 8 * ch) = pack8(a * wb, b * wb);
        *(LAS u32x4*)(K + row * RTP + 8 * ch) = R[2 + j]; *(LAS u32x4*)(V + row * RTP + 8 * ch) = R[4 + j]; }
    __syncthreads();
    if (next >= 0) rto_fetch(R, PJ, next, tid);
    const int r = lane & 15, q = lane >> 4;
    const int ih = wid >> 2, dvt = wid & 3;
    bf16x8 SB[2][2];
#pragma unroll
    for (int dr = 0; dr < 2; ++dr) { const bf16_t* st = RST + ((size_t)item * 2 + dr) * 64 * 64;
#pragma unroll
        for (int ks = 0; ks < 2; ++ks) SB[dr][ks] = *(const bf16x8*)(st + (size_t)(16 * dvt + r) * 64 + 32 * ks + 8 * q); }
    {
        f32x4 s[8];
#pragma unroll
        for (int it = 0; it < 8; ++it) s[it] = (f32x4){0.f, 0.f, 0.f, 0.f};
#pragma unroll
        for (int ks = 0; ks < 2; ++ks) { const bf16x8 A = ld_row(K, RTP, 16 * wid + r, 32 * ks + 8 * q);
#pragma unroll
            for (int it = 0; it < 8; ++it) { const bf16x8 B = ld_row(Q, RTP, 16 * it + r, 32 * ks + 8 * q); s[it] = MFMA16(A, B, s[it]); } }
#pragma unroll
        for (int it = 0; it < 8; ++it) { const int i = 16 * it + r; float v[4];
#pragma unroll
            for (int jj = 0; jj < 4; ++jj) { const int j = 16 * wid + 4 * q + jj; const int dd = i > j ? i - j : j - i; v[jj] = s[it][jj] * __builtin_amdgcn_exp2f((float)dd * lg); }
            st4bf(P + i * HGP + 16 * wid + 4 * q, v[0], v[1], v[2], v[3]); }
    }
    __syncthreads();
    f32x4 o[4];
#pragma unroll
    for (int it = 0; it < 4; ++it) o[it] = (f32x4){0.f, 0.f, 0.f, 0.f};
#pragma unroll
    for (int ks = 0; ks < 4; ++ks) { const bf16x8 B = ld_tr(V, RTP, 32 * ks + 8 * q, 16 * dvt + r, lane);
#pragma unroll
        for (int it = 0; it < 4; ++it) { const bf16x8 A = ld_row(P, HGP, 64 * ih + 16 * it + r, 32 * ks + 8 * q); o[it] = MFMA16(A, B, o[it]); } }
#pragma unroll
    for (int dr = 0; dr < 2; ++dr) { const LAS bf16_t* Qd = dr ? QB : QF;
#pragma unroll
        for (int ks = 0; ks < 2; ++ks) {
#pragma unroll
            for (int it = 0; it < 4; ++it) { const bf16x8 A = ld_row(Qd, RTP, 64 * ih + 16 * it + r, 32 * ks + 8 * q); o[it] = MFMA16(A, SB[dr][ks], o[it]); } } }
    const int fi = tid >> 2, fcc = tid & 3;
    const bf16_t* gp = PJ + pj_ret(3, h) + (t0 + fi) * 64 + 16 * fcc;
    const u32x4 gw0 = *(const u32x4*)gp, gw1 = *(const u32x4*)(gp + 8);
    __syncthreads();
    LAS float* OX = (LAS float*)lds;
#pragma unroll
    for (int it = 0; it < 4; ++it)
#pragma unroll
        for (int jj = 0; jj < 4; ++jj) OX[(64 * ih + 16 * it + 4 * q + jj) * 68 + 16 * dvt + r] = o[it][jj];
    __syncthreads();
    {
        const LAS f32x4* op = (const LAS f32x4*)(OX + fi * 68 + 16 * fcc);
        f32x4 v[4]; float ss = 0.f;
#pragma unroll
        for (int k = 0; k < 4; ++k) { v[k] = op[k]; ss += (v[k][0] * v[k][0] + v[k][1] * v[k][1]) + (v[k][2] * v[k][2] + v[k][3] * v[k][3]); }
        ss += __shfl_xor(ss, 1); ss += __shfl_xor(ss, 2);
        const float rs = rsqrtf(ss * (1.f / 64.f) + EPS);
        const float* wp = wn + 64 * h + 16 * fcc;
        bf16_t* outp = RET + (t0 + fi) * 1024 + 64 * h + 16 * fcc;
#pragma unroll
        for (int hh = 0; hh < 2; ++hh) {
            f32x4 g0, g1; unpack8(hh ? gw1 : gw0, g0, g1);
            const f32x4 w0 = *(const f32x4*)(wp + 8 * hh), w1 = *(const f32x4*)(wp + 8 * hh + 4);
            *(u32x4*)(outp + 8 * hh) = pack8(v[2 * hh] * rs * w0 * g0, v[2 * hh + 1] * rs * w1 * g1);
        }
    }
    __syncthreads();
}

DI void scan_phase(const bf16_t* __restrict__ dS, const float* __restrict__ HE, bf16_t* __restrict__ HST, const bf16_t* __restrict__ RSraw, bf16_t* __restrict__ RST, int nseq, int L, int gtid, int NT) {
    {
        const int NC = L / 64;
        for (int v = gtid; v < nseq * 16384; v += NT) {
            const int e = v & 2047, sd = v >> 11, dir = sd & 1, h = (sd >> 1) & 3, seq = sd >> 3, dv = e >> 4, dk8 = (e & 15) * 8;
            f32x4 S0 = (f32x4){0.f, 0.f, 0.f, 0.f}, S1 = S0;
            for (int n0 = 0; n0 < NC; n0 += 8) {
                u32x4 raw[8]; f32x4 e0[8], e1[8];
#pragma unroll
                for (int k = 0; k < 8; ++k) { const int nn = dir ? NC - 1 - (n0 + k) : n0 + k; const size_t it2 = ((size_t)(seq * NC + nn) * 4 + h) * 2 + dir;
                    raw[k] = *(const u32x4*)(dS + (it2 * 128 + dv) * 128 + dk8); e0[k] = *(const f32x4*)(HE + it2 * 128 + dk8); e1[k] = *(const f32x4*)(HE + it2 * 128 + dk8 + 4); }
#pragma unroll
                for (int k = 0; k < 8; ++k) { const int nn = dir ? NC - 1 - (n0 + k) : n0 + k; const size_t it2 = ((size_t)(seq * NC + nn) * 4 + h) * 2 + dir;
                    f32x4 a, b; unpack8(raw[k], a, b);
                    *(u32x4*)(HST + (it2 * 128 + dv) * 128 + dk8) = pack8(S0, S1);
                    S0 = e0[k] * S0 + a; S1 = e1[k] * S1 + b; }
            }
        }
    }
    {
        const int NC = L / 128;
        for (int v = gtid; v < nseq * 8192; v += NT) {
            const int e = v & 511, sd = v >> 9, dir = sd & 1, h = (sd >> 1) & 7, seq = sd >> 4, dv = e >> 3, dk8 = (e & 7) * 8;
            const float dec = __builtin_amdgcn_exp2f(128.f * lg2gamma(h));
            f32x4 S0 = (f32x4){0.f, 0.f, 0.f, 0.f}, S1 = S0;
            for (int n0 = 0; n0 < NC; n0 += 8) {
                u32x4 raw[8];
#pragma unroll
                for (int k = 0; k < 8; ++k) { const int nn = dir ? NC - 1 - (n0 + k) : n0 + k; const size_t it2 = ((size_t)(seq * NC + nn) * 8 + h) * 2 + dir;
                    raw[k] = *(const u32x4*)(RSraw + (it2 * 64 + dv) * 64 + dk8); }
#pragma unroll
                for (int k = 0; k < 8; ++k) { const int nn = dir ? NC - 1 - (n0 + k) : n0 + k; const size_t it2 = ((size_t)(seq * NC + nn) * 8 + h) * 2 + dir;
                    f32x4 a, b; unpack8(raw[k], a, b);
                    *(u32x4*)(RST + (it2 * 64 + dv) * 64 + dk8) = pack8(S0, S1);
                    S0 = S0 * dec + a; S1 = S1 * dec + b; }
            }
        }
    }
}

#define XB_TMO      128
#define XB_XCNT(j)  (256  + 64 * (j))
#define XB_XSUB(j)  (1280 + 64 * (j))
#define XB_XGEN(j)  (2304 + 64 * (j))
#define XB_TOP      3328
#define XB_TOPGEN   3392
#define XCD_BAR_WORDS 3456
#define XB_SPIN_CAP (1u << 18)
__device__ __forceinline__ unsigned xb_ld(unsigned* p)              { return __hip_atomic_load(p, __ATOMIC_RELAXED, __HIP_MEMORY_SCOPE_AGENT); }
__device__ __forceinline__ unsigned xb_add(unsigned* p, unsigned v) { return __hip_atomic_fetch_add(p, v, __ATOMIC_RELAXED, __HIP_MEMORY_SCOPE_AGENT); }
__device__ __forceinline__ unsigned xb_xcc_id() { return (unsigned)__builtin_amdgcn_s_getreg((3 << 11) | 20) & 0xFu; }
#define XB_SPIN(cond, bar) do { unsigned _sp = 0; while (cond) { __builtin_amdgcn_s_sleep(1); \
    if ((++_sp & 255u) == 0u) { if (xb_ld(&(bar)[XB_TMO])) break; if (_sp > XB_SPIN_CAP) { atomicAdd(&(bar)[XB_TMO], 1u); break; } } } } while (0)
struct XcdBarrier { unsigned* bar; unsigned x; volatile LAS unsigned* st; };
__device__ __forceinline__ XcdBarrier xcd_barrier_post(unsigned* bar, volatile LAS unsigned* st) {
    XcdBarrier b; b.bar = bar; b.x = xb_xcc_id(); b.st = st;
    if (threadIdx.x == 0) (void)xb_add(&bar[XB_XCNT(b.x)], 1u);
    return b;
}
__device__ __forceinline__ void xcd_barrier_complete(unsigned* bar, unsigned x, unsigned& nloc, unsigned& nx) {
    const unsigned G = gridDim.x * gridDim.y * gridDim.z;
    unsigned sum, cnt, mine, sp = 0u;
    for (;;) {
        sum = 0u; cnt = 0u; mine = 0u;
#pragma unroll
        for (unsigned j = 0; j < 16; ++j) { const unsigned c = xb_ld(&bar[XB_XCNT(j)]); sum += c; cnt += (c > 0u) ? 1u : 0u; mine = (j == x) ? c : mine; }
        if (sum == G) break;
        __builtin_amdgcn_s_sleep(1);
        if ((++sp & 255u) == 0u) { if (xb_ld(&bar[XB_TMO])) break; if (sp > XB_SPIN_CAP) { atomicAdd(&bar[XB_TMO], 1u); break; } }
    }
    nloc = mine > 0u ? mine : 1u; nx = cnt > 0u ? cnt : 1u;
}
__device__ __forceinline__ void xcd_barrier(const XcdBarrier& b) {
    asm volatile("s_waitcnt vmcnt(0)" ::: "memory");
    __syncthreads();
    if (threadIdx.x == 0) {
        unsigned* bar = b.bar;
        __builtin_amdgcn_s_waitcnt(0);
        unsigned nloc = b.st[0], nx = b.st[1];
        if (nloc == 0u) { xcd_barrier_complete(bar, b.x, nloc, nx); b.st[0] = nloc; b.st[1] = nx; }
        const unsigned old = xb_add(&bar[XB_XSUB(b.x)], 1u);
        const unsigned gen = old / nloc;
        if (old + 1u == (gen + 1u) * nloc) {
            __builtin_amdgcn_fence(__ATOMIC_RELEASE, "agent");
            asm volatile("s_waitcnt vmcnt(0)" ::: "memory");
            const unsigned og = xb_add(&bar[XB_TOP], 1u);
            const unsigned tg = og / nx;
            if (og + 1u == (tg + 1u) * nx) xb_add(&bar[XB_TOPGEN], 1u);
            else XB_SPIN(xb_ld(&bar[XB_TOPGEN]) == tg, bar);
            __builtin_amdgcn_fence(__ATOMIC_ACQUIRE, "agent");
            xb_add(&bar[XB_XGEN(b.x)], 1u);
            asm volatile("s_waitcnt vmcnt(0)" ::: "memory");
        } else {
            XB_SPIN(xb_ld(&bar[XB_XGEN(b.x)]) == gen, bar);
            __builtin_amdgcn_fence(__ATOMIC_ACQUIRE, "agent");
            asm volatile("s_waitcnt vmcnt(0)" ::: "memory");
        }
    }
    __syncthreads();
}
struct Args { const float* in[16]; float* out; unsigned char* ws; int lo, hi; };
constexpr int NPHASE = 14;

template <bool COOP>
__global__ void __launch_bounds__(NTHREADS) fwd(Args a) {
    extern __shared__ __attribute__((aligned(16))) unsigned char lds_raw[];
    LAS unsigned char* lds = (LAS unsigned char*)lds_raw;
    const int G = gridDim.x, bid = blockIdx.x;
    const int NT = G * NTHREADS, NGW = G * 8;
    unsigned char* ws = a.ws;
    float* OML = (float*)(ws + WS_OML); float* ROT = (float*)(ws + WS_ROT);
    bf16_t* WIN = (bf16_t*)(ws + WS_WIN); bf16_t* WR = (bf16_t*)(ws + WS_WR); bf16_t* WH = (bf16_t*)(ws + WS_WH); bf16_t* WO = (bf16_t*)(ws + WS_WO);
    bf16_t* WF = (bf16_t*)(ws + WS_WF); bf16_t* WD = (bf16_t*)(ws + WS_WD); bf16_t* HN = (bf16_t*)(ws + WS_HN);
    float* SS1 = (float*)(ws + WS_SS1); float* SS2 = (float*)(ws + WS_SS2); float* HE = (float*)(ws + WS_HE);
    bf16_t* RSRAW = (bf16_t*)(ws + WS_RSRAW); bf16_t* RST = (bf16_t*)(ws + WS_RST); bf16_t* HST = (bf16_t*)(ws + WS_HST);
    bf16_t* PJ = (bf16_t*)(ws + WS_PJ); bf16_t* GB = (bf16_t*)(ws + WS_G);
    bf16_t* RET = (bf16_t*)(ws + WS_RET); bf16_t* MG = (bf16_t*)(ws + WS_MG); bf16_t* A2 = (bf16_t*)(ws + WS_A2); float* SIDE = (float*)(ws + WS_SIDE);
    const int lo = a.lo, hi = a.hi;
    XcdBarrier xbar; xbar.bar = (unsigned*)(ws + WS_BAR); xbar.x = 0; xbar.st = nullptr;
    if (COOP) {
        volatile LAS unsigned* stw = (volatile LAS unsigned*)(lds + LDS_BARW);
        if (threadIdx.x < 2) stw[threadIdx.x] = 0u;
        __syncthreads();
        xbar = xcd_barrier_post((unsigned*)(ws + WS_BAR), stw);
    }
    int seq = 0;
#ifndef MK_MASK
#define MK_MASK 0xfff
#endif
#define PH_BEGIN(k) if (((MK_MASK >> (k)) & 1) && lo <= seq && seq < hi) { \
    const int tid = opaque(threadIdx.x), lane = tid & 63, wid = __builtin_amdgcn_readfirstlane(tid >> 6); \
    const int gtid = bid * NTHREADS + tid, gw = bid * 8 + wid; (void)lane; (void)gtid; (void)gw;
#define PH_END   if (COOP && seq + 1 < hi) { if (lo < 0) cg::this_grid().sync(); else xcd_barrier(xbar); } } ++seq;

    PH_BEGIN(0)
        LAS float* scr = (LAS float*)(lds + wid * 16384);
        constexpr int I_IN = 16 * 208, I_R = 8 * 32, I_H = 8 * 32, I_O = 16 * 32, I_F = 16 * 176, I_D = 44 * 32;
        constexpr int NIT = I_IN + I_R + I_H + I_O + I_F + I_D;
        for (int it = gw; it < NIT; it += NGW) {
            int r = it;
            if (r < I_IN) { p0_item<1>(a.in[2], 1024, DIN, WIN, nullptr, scr, r, 208, lane); continue; } r -= I_IN;
            if (r < I_R) { p0_item<0>(a.in[6], 512, 1024, WR, nullptr, scr, r, 32, lane, 1024, 0); continue; } r -= I_R;
            if (r < I_H) { p0_item<0>(a.in[7], 512, 1024, WR, nullptr, scr, r, 32, lane, 1024, 512); continue; } r -= I_H;
            if (r < I_O) { p0_item<0>(a.in[8], 1024, 1024, WO, nullptr, scr, r, 32, lane); continue; } r -= I_O;
            if (r < I_F) { p0_item<2>(a.in[11], 1024, NFF2, WF, a.in[10], scr, r, 176, lane); continue; } r -= I_F;
            p0_item<0>(a.in[14], DFF, 1024, WD, nullptr, scr, r, 32, lane);
        }
        for (int i = gtid; i < 4096 * 32; i += NT) {
            const int pos = i >> 5, fi = i & 31;
            const float invf = __builtin_amdgcn_exp2f(-(float)fi * 0.4152410118609203f);
            const float ang = (float)pos * invf;
            const double rev = (double)ang * 0.15915494309189535; const float fr = (float)(rev - floor(rev));
            ROT[i] = __builtin_amdgcn_cosf(fr); ROT[4096 * 32 + i] = __builtin_amdgcn_sinf(fr);
        }
        for (int i = gtid; i < 1024; i += NT) { const float l0 = a.in[3][i], l1 = a.in[3][1024 + i]; OML[i] = sigm(l1 - l0); }
        for (int m = gw; m < MH; m += NGW) {
            const f32x4* x0 = (const f32x4*)(a.in[0] + (size_t)m * D) + lane; const f32x4* x1 = (const f32x4*)(a.in[1] + (size_t)m * D) + lane;
            f32x4 v0[4], v1[4]; float s0 = 0.f, s1 = 0.f;
#pragma unroll
            for (int j = 0; j < 4; ++j) { v0[j] = x0[64 * j]; v1[j] = x1[64 * j]; }
#pragma unroll
            for (int j = 0; j < 4; ++j) { s0 += (v0[j][0] * v0[j][0] + v0[j][1] * v0[j][1]) + (v0[j][2] * v0[j][2] + v0[j][3] * v0[j][3]); s1 += (v1[j][0] * v1[j][0] + v1[j][1] * v1[j][1]) + (v1[j][2] * v1[j][2] + v1[j][3] * v1[j][3]); }
            const float r0 = rsqrtf(wave_sum(s0) * (1.f / D) + EPS), r1 = rsqrtf(wave_sum(s1) * (1.f / D) + EPS);
            u32x2* o0 = (u32x2*)(HN + (size_t)m * D) + lane; u32x2* o1 = (u32x2*)(HN + (size_t)(MH + m) * D) + lane;
#pragma unroll
            for (int j = 0; j < 4; ++j) { const f32x4 wv = ((const f32x4*)a.in[9])[lane + 64 * j]; const f32x4 y0 = v0[j] * r0 * wv, y1 = v1[j] * r1 * wv;
                u32x2 p0; p0.x = pk2(y0[0], y0[1]); p0.y = pk2(y0[2], y0[3]); o0[64 * j] = p0; u32x2 p1; p1.x = pk2(y1[0], y1[1]); p1.y = pk2(y1[2], y1[3]); o1[64 * j] = p1; }
        }
    PH_END

    for (int g = 0; g < 2; ++g) {
        const int L = g ? 4096 : 2048, nseq = g ? 8 : 16;
        const float* xin = a.in[g]; float* outh = a.out + (size_t)g * MH * D;
        bf16_t* DSRAW = (bf16_t*)outh;
        PH_BEGIN(1)
            pg8::Gemm gm{HN + (size_t)g * MH * D, WIN, MH, DIN, D}; pg8::StaticOrder S; S.init(MH, DIN, G, bid);
            EpiProj E{PJ, ROT, OML, L - 1};
            pg8::gemm_phase<EpiProj, pg8::StaticOrder, true, true>(lds, gm, S, E);
        PH_END
        PH_BEGIN(2)
            if (wid >= 4) __builtin_amdgcn_s_setprio(1);
            { u32x4 R[6]; hgs_fetch(R, PJ, bid, tid);
              for (int it = bid; it < 2048; it += G) hg_state_item(lds, PJ, DSRAW, HE, it, it + G < 2048 ? it + G : -1, R, tid, lane, wid); }
            { u32x4 R[4]; rts_fetch(R, PJ, bid, tid);
              for (int it = bid; it < 2048; it += G) ret_state_item(lds, PJ, RSRAW, it, it + G < 2048 ? it + G : -1, R, tid, lane, wid); }
            __builtin_amdgcn_s_setprio(0);
        PH_END
        PH_BEGIN(3)
            scan_phase(DSRAW, HE, HST, RSRAW, RST, nseq, L, gtid, NT);
        PH_END
        PH_BEGIN(4)
            if (wid >= 4) __builtin_amdgcn_s_setprio(1);
            { u32x4 R[8]; hgo_fetch(R, PJ, bid, tid);
              for (int it = bid; it < 2048; it += G) hg_out_item(lds, PJ, HST, a.in[5], (bf16_t*)a.out + (size_t)g * MH * D, it, it + G < 2048 ? it + G : -1, R, tid, lane, wid); }
            { u32x4 R[6]; rto_fetch(R, PJ, bid, tid);
              for (int it = bid; it < 2048; it += G) ret_out_item(lds, PJ, RST, a.in[4], (bf16_t*)a.out + (size_t)g * MH * D, it, it + G < 2048 ? it + G : -1, R, tid, lane, wid); }
            __builtin_amdgcn_s_setprio(0);
        PH_END
        if (g == 1) {
        PH_BEGIN(5)
            pg8::Gemm gm{(const bf16_t*)a.out, WR, 2 * MH, D, D}; pg8::StaticOrder S; S.init(2 * MH, D, G, bid);
            EpiMerge2 E{PJ + PJ_G0, MG};
            pg8::gemm_phase<EpiMerge2, pg8::StaticOrder, true, true>(lds, gm, S, E);
        PH_END
        }
    }
    {
        const int g = 0; (void)g;
        PH_BEGIN(7)
            pg8::Gemm gm{MG, WO, 2 * MH, D, D}; pg8::StaticOrder S; S.init(2 * MH, D, G, bid);
            EpiRes E{a.in[0], a.in[1], a.out, A2, SS1};
            pg8::gemm_phase<EpiRes, pg8::StaticOrder, true, true>(lds, gm, S, E);
        PH_END
        PH_BEGIN(8)
            pg8::Gemm gm{A2, WF, 2 * MH, NFF2, D}; pg8::StaticOrder S; S.init(2 * MH, NFF2, G, bid);
            EpiFfn E{SS1, a.in[12], a.in[13], GB, SIDE, (LAS float*)(lds + 131072)};
            pg8::gemm_phase<EpiFfn, pg8::StaticOrder, true, true>(lds, gm, S, E);
        PH_END
        PH_BEGIN(9)
            ffn_fixup_phase(SIDE, a.in[12], GB, gtid, NT);
        PH_END
        PH_BEGIN(10)
            pg8::Gemm gm{GB, WD, 2 * MH, D, DFF}; pg8::StaticOrder S; S.init(2 * MH, D, G, bid);
            EpiFinal E{a.out, a.out, a.in[15], SS2, (unsigned*)(ws + WS_CNT), lds + 131072 + 4096};
            pg8::gemm_phase<EpiFinal, pg8::StaticOrder, true, true>(lds, gm, S, E);
        PH_END
    }
#undef PH_BEGIN
#undef PH_END
}

extern "C" void kernel_launch(void* const* d_in, const int* in_sizes, int n_in, void* d_out, int out_size, void* d_ws, size_t ws_size, hipStream_t stream) {
    static int grid = 0;
    if (grid == 0) {
        if (n_in != 16 || ws_size < WS_END) { fprintf(stderr, "kernel_launch: unexpected inputs (n_in %d, ws %zu)\n", n_in, ws_size); grid = -1; return; }
        int dev = 0, cus = 0, per_cu = 0;
        hipGetDevice(&dev); hipDeviceGetAttribute(&cus, hipDeviceAttributeMultiprocessorCount, dev);
#if MK_COOP
        hipFuncSetAttribute((const void*)fwd<true>, hipFuncAttributeMaxDynamicSharedMemorySize, LDS_BYTES);
#endif
#if !MK_COOP
        hipFuncSetAttribute((const void*)fwd<false>, hipFuncAttributeMaxDynamicSharedMemorySize, LDS_BYTES);
#endif
        hipOccupancyMaxActiveBlocksPerMultiprocessor(&per_cu, (const void*)fwd<(MK_COOP != 0)>, NTHREADS, LDS_BYTES);
        if (per_cu < 1) { fprintf(stderr, "kernel_launch: occupancy query says %d blocks per CU\n", per_cu); per_cu = 1; }
        (void)hipGetLastError();
        grid = cus * 1;
    }
    if (grid < 0) return;
    Args a{};
    for (int i = 0; i < 16; ++i) a.in[i] = (const float*)d_in[i];
    a.out = (float*)d_out; a.ws = (unsigned char*)d_ws;
#if MK_COOP
    (void)hipMemsetAsync((char*)d_ws + WS_BAR, 0, 131072, stream);
    a.lo = 0; a.hi = NPHASE;
    void* args[] = {&a};
    hipError_t e = hipLaunchCooperativeKernel((const void*)fwd<true>, dim3(grid), dim3(NTHREADS), args, LDS_BYTES, stream);
    if (e != hipSuccess) fprintf(stderr, "cooperative launch failed: %s (grid %d)\n", hipGetErrorString(e), grid);
#else
    for (int s = 0; s < NPHASE; ++s) { a.lo = s; a.hi = s + 1; hipLaunchKernelGGL(fwd<false>, dim3(grid), dim3(NTHREADS), LDS_BYTES, stream, a); }
#endif
}
```

```cpp
#include <hip/hip_runtime.h>
#include <hip/hip_cooperative_groups.h>
#include <cstdio>
#include <cstdint>
namespace cg = cooperative_groups;

#ifndef MK_COOP
#define MK_COOP 1
#endif

#define LAS __attribute__((address_space(3)))
#define DI __device__ __forceinline__
typedef unsigned short bf16_t;
typedef short bf16x8 __attribute__((ext_vector_type(8)));
typedef float f32x4 __attribute__((ext_vector_type(4)));
typedef unsigned u32x4 __attribute__((ext_vector_type(4)));
typedef unsigned u32x2 __attribute__((ext_vector_type(2)));

constexpr int D = 1024, DIN = 6656, DFF = 2816, NFF2 = 5632;
constexpr int MH = 32768;
constexpr float EPS = 1e-6f;
constexpr int NTHREADS = 512;
constexpr int C_RQ = 0, C_RK = 512, C_RV = 1024, C_RG = 1536, C_HQ = 2048, C_HFF = 2560, C_HFB = 3072, C_HI = 3584, C_HG = 4096, C_GA = 4608, C_GB = 5632;

__device__ __forceinline__ float lg2gamma(int h) {
    float r = -0.04580368961312479f;
    r = h == 1 ? -0.02272007650008353f : r; r = h == 2 ? -0.011315313227834146f : r; r = h == 3 ? -0.005646563141142063f : r;
    r = h == 4 ? -0.0028205190623786626f : r; r = h == 5 ? -0.0014095702546713536f : r; r = h == 6 ? -0.0007046129765893727f : r; r = h == 7 ? -0.0003522634716290214f : r;
    return r;
}

constexpr size_t MiB = 1u << 20;
constexpr size_t WS_OML = 0;
constexpr size_t WS_ROT = 1 * MiB;
constexpr size_t WS_WIN = 2 * MiB;
constexpr size_t WS_WR = 15 * MiB;
constexpr size_t WS_WH = 16 * MiB;
constexpr size_t WS_WO = 17 * MiB;
constexpr size_t WS_WF = 19 * MiB;
constexpr size_t WS_WD = 30 * MiB;
constexpr size_t WS_HN = 36 * MiB;
constexpr size_t WS_SS1 = 164 * MiB;
constexpr size_t WS_SS2 = 168 * MiB;
constexpr size_t WS_HE = 168 * MiB;
constexpr size_t WS_RSRAW = 170 * MiB;
constexpr size_t WS_RST = 202 * MiB;
constexpr size_t WS_HST = 234 * MiB;
constexpr size_t WS_PJ = 362 * MiB;
constexpr size_t WS_G = 362 * MiB;
constexpr size_t WS_RET = 778 * MiB;
constexpr size_t WS_MG = 842 * MiB;
constexpr size_t WS_A2 = 170 * MiB;
constexpr size_t WS_SIDE = 970 * MiB;
constexpr size_t WS_END = 990 * MiB;

constexpr size_t WS_CNT = 131072;
constexpr size_t WS_BAR = 65536;
constexpr size_t PJ_HG0 = (size_t)2048 * MH, PJ_G0 = (size_t)4608 * MH;
__host__ __device__ __forceinline__ size_t pj_ret(int stream, int hd) { return ((size_t)(stream * 8 + hd) * MH) * 64; }
__host__ __device__ __forceinline__ size_t pj_hg(int stream, int hd) { return PJ_HG0 + ((size_t)(stream * 4 + hd) * MH) * 128; }
constexpr int LDS_BYTES = 147456;
constexpr int LDS_BARW = 147456 - 64;

DI float bf2f(unsigned short b) { return __uint_as_float((unsigned)b << 16); }
DI float bflo(unsigned u) { return __uint_as_float(u << 16); }
DI float bfhi(unsigned u) { return __uint_as_float(u & 0xffff0000u); }
typedef __bf16 bf16v2_t __attribute__((ext_vector_type(2)));
DI unsigned pk2(float lo, float hi) { bf16v2_t v; v[0] = (__bf16)lo; v[1] = (__bf16)hi; return __builtin_bit_cast(unsigned, v); }
DI unsigned short f2bf(float f) { return (unsigned short)(pk2(f, 0.f) & 0xffffu); }
DI float sigm(float x) { return __builtin_amdgcn_rcpf(1.f + __builtin_amdgcn_exp2f(-1.4426950408889634f * x)); }
DI f32x4 sig4_exp2(f32x4 t) {
    f32x4 d;
#pragma unroll
    for (int j = 0; j < 4; ++j) d[j] = 1.f + __builtin_amdgcn_exp2f(fminf(t[j], 28.853900817779268f));
    const float p01 = d[0] * d[1], p23 = d[2] * d[3];
    const float rr = __builtin_amdgcn_rcpf(p01 * p23);
    const float r01 = rr * p23, r23 = rr * p01;
    return (f32x4){r01 * d[1], r01 * d[0], r23 * d[3], r23 * d[2]};
}
DI int opaque(int x) { asm volatile("" : "+v"(x)); return x; }
DI float wave_sum(float v) {
#pragma unroll
    for (int o = 1; o < 64; o <<= 1) v += __shfl_xor(v, o);
    return v;
}
DI u32x4 pack8(const f32x4 a, const f32x4 b) { u32x4 w; w.x = pk2(a[0], a[1]); w.y = pk2(a[2], a[3]); w.z = pk2(b[0], b[1]); w.w = pk2(b[2], b[3]); return w; }
DI void unpack8(const u32x4 w, f32x4& a, f32x4& b) { a = (f32x4){bflo(w.x), bfhi(w.x), bflo(w.y), bfhi(w.y)}; b = (f32x4){bflo(w.z), bfhi(w.z), bflo(w.w), bfhi(w.w)}; }
#define MFMA16(a, b, c) __builtin_amdgcn_mfma_f32_16x16x32_bf16((a), (b), (c), 0, 0, 0)

namespace pg8 {
constexpr int BM = 256, BK = 64, HALF = 128, HTB = HALF * BK * 2, STAGE_BYTES = 8 * HTB, NXCD = 8, WGM = 8;
__host__ __device__ __forceinline__ int lds_byte(int r, int c) { const int st = (r >> 4) * 2 + (c >> 5), rr = r & 15, cc = c & 31, ob = rr * 64 + cc * 2; return st * 1024 + (ob ^ (((ob >> 9) & 1) << 5)); }
__host__ __device__ __forceinline__ void stage_rc(int b, int& R, int& C) { const int st = b / 1024, sb = b % 1024, swz = sb ^ (((sb >> 9) & 1) << 5); R = (st >> 1) * 16 + swz / 64; C = (st & 1) * 32 + (swz % 64) / 2; }
__host__ __device__ __forceinline__ int perm32(int rho) { const int n = rho >> 4, i = rho & 15; return 8 * (i >> 2) + 4 * n + (i & 3); }

struct Unit { int pm, pn; };
struct Gemm { const bf16_t* A; const bf16_t* Bt; int M, N, K; };

struct StaticOrder {
    int nM, nN, nwg, G, c;
    __host__ __device__ void init(int M, int N, int G_, int c_) { nM = M / BM; nN = N / BM; nwg = nM * nN; G = G_; c = c_; }
    __host__ __device__ bool next(int i, Unit& u) const {
        const long L = (long)i * G + c; if (L >= nwg) return false;
        int wgid = (int)L; { const int q = nwg / NXCD, r = nwg % NXCD, xcd = wgid % NXCD, off = wgid / NXCD; wgid = (xcd < r ? xcd * (q + 1) : r * (q + 1) + (xcd - r) * q) + off; }
        const int nig = WGM * nN, gid = wgid / nig, fm = gid * WGM, gsz = (nM - fm) < WGM ? (nM - fm) : WGM;
        u.pm = fm + ((wgid % nig) % gsz); u.pn = (wgid % nig) / gsz; return true;
    }
    __device__ __forceinline__ void a_ready(const Unit&) const {}
    __device__ __forceinline__ void done(const Unit&) const {}
};

template <class Epi, class Sched, bool ALIGN_EPI = false, bool SP2 = false>
__device__ __forceinline__ void gemm_phase(LAS unsigned char* lds, const Gemm g, const Sched& S, const Epi& E) {
    const int tid = opaque(threadIdx.x), wid = __builtin_amdgcn_readfirstlane(tid >> 6), lane = tid & 63, wr = wid >> 2, wc = wid & 3, fr = lane & 15, fq = lane >> 4;
    const int K = g.K, nt = K / BK;
    unsigned voffA[2], voffB[2];
#pragma unroll
    for (int i = 0; i < 2; ++i) { int R, C; stage_rc(tid * 16 + i * 8192, R, C); const int Rb = Epi::PERM ? ((R & ~31) + perm32(R & 31)) : R;
        voffA[i] = (unsigned)(R * K + C) * 2u; voffB[i] = (unsigned)(Rb * K + C) * 2u; }
    const size_t kstep = (size_t)(BK * 2);
    const size_t hstep = (size_t)HALF * K * 2;
    const size_t tstep = 2 * hstep;
    const unsigned ldsw = (unsigned)wid * 1024u;
    const int aoff = lds_byte(wr * 64 + fr, fq * 8), boff = lds_byte(wc * 32 + fr, fq * 8);
#define PG8_SA(b, h) (((b) * 2 + (h)) * HTB)
#define PG8_SB(b, h) ((4 + (b) * 2 + (h)) * HTB)
#define PG8_STAGE(bufoff, gbase, voff) do { _Pragma("unroll") for (int _i = 0; _i < 2; ++_i) \
        __builtin_amdgcn_global_load_lds((const unsigned*)((const char*)(gbase) + (voff)[_i]), (LAS unsigned*)(lds + (bufoff) + ldsw + _i * 8192), 16, 0, 0); } while (0)
#define PG8_LDA(dst, b, h) do { _Pragma("unroll") for (int m = 0; m < 4; ++m) _Pragma("unroll") for (int k = 0; k < 2; ++k) dst[m][k] = *(const LAS bf16x8*)(lds + PG8_SA(b, h) + aoff + m * 2048 + k * 1024); } while (0)
#define PG8_LDB(dst, b, h) do { _Pragma("unroll") for (int n = 0; n < 2; ++n) _Pragma("unroll") for (int k = 0; k < 2; ++k) dst[n][k] = *(const LAS bf16x8*)(lds + PG8_SB(b, h) + boff + n * 2048 + k * 1024); } while (0)
#define PG8_MMA(ai, bj, At, Bt) do { __builtin_amdgcn_s_setprio(1); _Pragma("unroll") for (int m = 0; m < 4; ++m) _Pragma("unroll") for (int n = 0; n < 2; ++n) _Pragma("unroll") for (int k = 0; k < 2; ++k) \
        acc[ai][bj][m][n] = __builtin_amdgcn_mfma_f32_16x16x32_bf16(Bt[n][k], At[m][k], acc[ai][bj][m][n], 0, 0, 0); __builtin_amdgcn_s_setprio(0); } while (0)
#define PG8_WAIT_V(n) asm volatile("s_waitcnt vmcnt(" #n ")" ::: "memory")
#define PG8_WAIT_L(n) asm volatile("s_waitcnt lgkmcnt(" #n ")" ::: "memory")
#define PG8_BAR __builtin_amdgcn_s_barrier()
#define PG8_SCHED __builtin_amdgcn_sched_barrier(0)
    Unit cur, nxt; int ui = 0;
    if (!S.next(0, cur)) return;
    f32x4 acc[2][2][4][2];
#pragma unroll
    for (int a = 0; a < 2; ++a)
#pragma unroll
        for (int b = 0; b < 2; ++b)
#pragma unroll
            for (int m = 0; m < 4; ++m)
#pragma unroll
                for (int n = 0; n < 2; ++n) acc[a][b][m][n] = (f32x4){0.f, 0.f, 0.f, 0.f};
    bf16x8 At[4][2], B0[2][2], B1[2][2];
    const char* cA = (const char*)g.A + (size_t)cur.pm * tstep; const char* cB = (const char*)g.Bt + (size_t)cur.pn * tstep;
    S.a_ready(cur);
    if constexpr (SP2) {
        PG8_STAGE(PG8_SB(0, 0), cB, voffB); PG8_STAGE(PG8_SB(0, 1), cB + hstep, voffB); PG8_STAGE(PG8_SA(0, 0), cA, voffA); PG8_STAGE(PG8_SA(0, 1), cA + hstep, voffA);
        if (wr == 1) PG8_BAR;
        PG8_WAIT_V(2); PG8_BAR;
        PG8_STAGE(PG8_SB(1, 0), cB + kstep, voffB); PG8_STAGE(PG8_SA(1, 0), cA + kstep, voffA); PG8_STAGE(PG8_SB(1, 1), cB + hstep + kstep, voffB);
        PG8_WAIT_V(6); PG8_BAR;
    } else {
        PG8_STAGE(PG8_SB(0, 0), cB, voffB); PG8_STAGE(PG8_SA(0, 0), cA, voffA); PG8_STAGE(PG8_SB(0, 1), cB + hstep, voffB); PG8_STAGE(PG8_SA(0, 1), cA + hstep, voffA);
        if (wr == 1) PG8_BAR;
        PG8_WAIT_V(4); PG8_BAR;
        PG8_STAGE(PG8_SB(1, 0), cB + kstep, voffB); PG8_STAGE(PG8_SA(1, 0), cA + kstep, voffA); PG8_STAGE(PG8_SB(1, 1), cB + hstep + kstep, voffB);
        PG8_WAIT_V(6); PG8_BAR;
    }
    for (;;) {
        const bool has_next = S.next(ui + 1, nxt);
        const char* nA = has_next ? (const char*)g.A + (size_t)nxt.pm * tstep : cA; const char* nB = has_next ? (const char*)g.Bt + (size_t)nxt.pn * tstep : cB;
        for (int t = 0; t < nt; t += 2) {
            const bool last = (t == nt - 2);
            const char* a1 = cA + (size_t)(t + 1) * kstep;
            const char* a2 = last ? nA : cA + (size_t)(t + 2) * kstep; const char* b2 = last ? nB : cB + (size_t)(t + 2) * kstep;
            const char* a3 = a2 + kstep; const char* b3 = b2 + kstep;
            if (last && has_next) S.a_ready(nxt);
            if constexpr (Epi::MIDK) { if (t == nt / 2) E.mid(acc, cur, wr, wc, fr, fq); }
            if constexpr (SP2) {
            PG8_LDB(B0, 0, 0); PG8_LDB(B1, 0, 1); PG8_SCHED; PG8_LDA(At, 0, 0); PG8_STAGE(PG8_SA(1, 1), a1 + hstep, voffA);
            PG8_WAIT_V(8); PG8_WAIT_L(0); PG8_BAR; PG8_MMA(0, 0, At, B0); PG8_MMA(0, 1, At, B1); PG8_BAR; PG8_SCHED;
            PG8_LDA(At, 0, 1); PG8_STAGE(PG8_SB(0, 0), b2, voffB); PG8_STAGE(PG8_SB(0, 1), b2 + hstep, voffB); PG8_STAGE(PG8_SA(0, 0), a2, voffA);
            PG8_WAIT_V(8); PG8_WAIT_L(0); PG8_BAR; PG8_MMA(1, 0, At, B0); PG8_MMA(1, 1, At, B1); PG8_BAR; PG8_SCHED;
            PG8_LDB(B0, 1, 0); PG8_LDB(B1, 1, 1); PG8_SCHED; PG8_LDA(At, 1, 0); PG8_STAGE(PG8_SA(0, 1), a2 + hstep, voffA);
            PG8_WAIT_V(8); PG8_WAIT_L(0); PG8_BAR; PG8_MMA(0, 0, At, B0); PG8_MMA(0, 1, At, B1); PG8_BAR; PG8_SCHED;
            PG8_LDA(At, 1, 1); PG8_STAGE(PG8_SB(1, 0), b3, voffB); PG8_STAGE(PG8_SB(1, 1), b3 + hstep, voffB); PG8_STAGE(PG8_SA(1, 0), a3, voffA);
            PG8_WAIT_V(8); PG8_WAIT_L(0); PG8_BAR; PG8_MMA(1, 0, At, B0); PG8_MMA(1, 1, At, B1); PG8_BAR; PG8_SCHED;
            } else {
            PG8_LDB(B0, 0, 0); PG8_SCHED; PG8_LDA(At, 0, 0); PG8_STAGE(PG8_SA(1, 1), a1 + hstep, voffA);
            PG8_WAIT_L(8); PG8_BAR; PG8_WAIT_L(0); PG8_MMA(0, 0, At, B0); PG8_BAR; PG8_SCHED;
            PG8_LDB(B1, 0, 1); PG8_STAGE(PG8_SB(0, 0), b2, voffB);
            PG8_BAR; PG8_WAIT_L(0); PG8_MMA(0, 1, At, B1); PG8_BAR;
            PG8_LDA(At, 0, 1); PG8_STAGE(PG8_SA(0, 0), a2, voffA);
            PG8_BAR; PG8_WAIT_L(0); PG8_MMA(1, 0, At, B0); PG8_BAR; PG8_SCHED;
            PG8_STAGE(PG8_SB(0, 1), b2 + hstep, voffB);
            PG8_WAIT_V(6); PG8_BAR; PG8_MMA(1, 1, At, B1); PG8_BAR;
            PG8_LDB(B0, 1, 0); PG8_SCHED; PG8_LDA(At, 1, 0); PG8_STAGE(PG8_SA(0, 1), a2 + hstep, voffA);
            PG8_WAIT_L(8); PG8_BAR; PG8_WAIT_L(0); PG8_MMA(0, 0, At, B0); PG8_BAR; PG8_SCHED;
            PG8_LDB(B1, 1, 1); PG8_STAGE(PG8_SB(1, 0), b3, voffB);
            PG8_BAR; PG8_WAIT_L(0); PG8_MMA(0, 1, At, B1); PG8_BAR;
            PG8_LDA(At, 1, 1); PG8_STAGE(PG8_SA(1, 0), a3, voffA);
            PG8_BAR; PG8_WAIT_L(0); PG8_MMA(1, 0, At, B0); PG8_BAR; PG8_SCHED;
            PG8_STAGE(PG8_SB(1, 1), b3 + hstep, voffB);
            PG8_WAIT_V(6); PG8_BAR; PG8_MMA(1, 1, At, B1); PG8_BAR;
            }
        }
        if constexpr (ALIGN_EPI) { if (wr == 0) PG8_BAR; }
        E(acc, cur, wr, wc, fr, fq); S.done(cur);
        if (!has_next) break;
#pragma unroll
        for (int a = 0; a < 2; ++a)
#pragma unroll
            for (int b = 0; b < 2; ++b)
#pragma unroll
                for (int m = 0; m < 4; ++m)
#pragma unroll
                    for (int n = 0; n < 2; ++n) acc[a][b][m][n] = (f32x4){0.f, 0.f, 0.f, 0.f};
        cur = nxt; cA = nA; cB = nB; ++ui;
        if constexpr (ALIGN_EPI) { if (wr == 1) PG8_BAR; }
    }
    PG8_WAIT_V(0);
    if constexpr (!ALIGN_EPI) { if (wr == 0) PG8_BAR; }
    PG8_BAR;
#undef PG8_SA
#undef PG8_SB
#undef PG8_STAGE
#undef PG8_LDA
#undef PG8_LDB
#undef PG8_MMA
#undef PG8_WAIT_V
#undef PG8_WAIT_L
#undef PG8_BAR
#undef PG8_SCHED
}
}
using pg8::Unit;

typedef f32x4 AccT[2][2][4][2];

struct EpiProj {
    static constexpr bool PERM = true, MIDK = false;
    bf16_t* O; const float* rot; const float* oml; int Lmask;
    DI void operator()(const AccT& acc, const Unit& u, int wr, int wc, int fr, int fq) const {
        const int pn = u.pn;
        const int row0 = u.pm * 256 + wr * 64 + fr;
        size_t base[2]; int rp;
#pragma unroll
        for (int bj = 0; bj < 2; ++bj) {
            if (pn < 8) { rp = 64; base[bj] = pj_ret(pn >> 1, (pn & 1) * 4 + bj * 2 + (wc >> 1)) + (wc & 1) * 32 + 8 * fq; }
            else if (pn < 18) { rp = 128; base[bj] = pj_hg((pn - 8) >> 1, (pn & 1) * 2 + bj) + wc * 32 + 8 * fq; }
            else { rp = 2048; base[bj] = PJ_G0 + (pn - 18) * 256 + bj * 128 + wc * 32 + 8 * fq; }
        }
        int mode;
        if (pn < 4) mode = 4; else if (pn < 6) mode = 0; else if (pn < 10) mode = 1; else if (pn < 14) mode = 3; else if (pn < 16) mode = 0; else if (pn < 18) mode = 1; else mode = 2;
        if (mode == 4) {
            const float sc = pn < 2 ? 1.f : 0.125f;
            const int fi = 16 * (wc & 1) + 4 * fq;
#pragma unroll
            for (int ai = 0; ai < 2; ++ai)
#pragma unroll
                for (int m = 0; m < 4; ++m) {
                    const int row = row0 + ai * 128 + m * 16; const int pos = row & Lmask;
                    const f32x4 cs = *(const f32x4*)(rot + pos * 32 + fi) * sc, sn = *(const f32x4*)(rot + 4096 * 32 + pos * 32 + fi) * sc;
#pragma unroll
                    for (int bj = 0; bj < 2; ++bj) {
                        const f32x4 x1 = acc[ai][bj][m][0], x2 = acc[ai][bj][m][1];
                        const f32x4 o1 = x1 * cs - x2 * sn, o2 = x1 * sn + x2 * cs;
                        *(u32x4*)(O + base[bj] + (size_t)row * rp) = pack8(o1, o2);
                    }
                }
        } else if (mode == 0) {
#pragma unroll
            for (int ai = 0; ai < 2; ++ai)
#pragma unroll
                for (int m = 0; m < 4; ++m) {
                    const size_t row = (size_t)(row0 + ai * 128 + m * 16);
#pragma unroll
                    for (int bj = 0; bj < 2; ++bj) *(u32x4*)(O + base[bj] + row * rp) = pack8(acc[ai][bj][m][0], acc[ai][bj][m][1]);
                }
        } else if (mode == 2) {
#pragma unroll
            for (int ai = 0; ai < 2; ++ai)
#pragma unroll
                for (int m = 0; m < 4; ++m) {
                    const size_t row = (size_t)(row0 + ai * 128 + m * 16);
#pragma unroll
                    for (int bj = 0; bj < 2; ++bj)
                        *(u32x4*)(O + base[bj] + row * rp) = pack8(sig4_exp2(acc[ai][bj][m][0] * -1.4426950408889634f), sig4_exp2(acc[ai][bj][m][1] * -1.4426950408889634f));
                }
        } else {
            f32x4 om[2][2];
#pragma unroll
            for (int bj = 0; bj < 2; ++bj)
#pragma unroll
                for (int n = 0; n < 2; ++n) om[bj][n] = (f32x4){1.f, 1.f, 1.f, 1.f};
            if (mode == 3) {
                const float* op = oml + (pn >= 12 ? 512 : 0) + (pn & 1) * 256 + wc * 32 + 8 * fq;
#pragma unroll
                for (int bj = 0; bj < 2; ++bj)
#pragma unroll
                    for (int n = 0; n < 2; ++n) om[bj][n] = *(const f32x4*)(op + bj * 128 + 4 * n);
            }
            const float sgn = (mode == 3) ? 1.4426950408889634f : -1.4426950408889634f;
#pragma unroll
            for (int ai = 0; ai < 2; ++ai)
#pragma unroll
                for (int m = 0; m < 4; ++m) {
                    const size_t row = (size_t)(row0 + ai * 128 + m * 16);
#pragma unroll
                    for (int bj = 0; bj < 2; ++bj) {
                        f32x4 y[2];
#pragma unroll
                        for (int n = 0; n < 2; ++n) {
                            const f32x4 x = acc[ai][bj][m][n];
                            const f32x4 sg = sig4_exp2(x * sgn);
                            y[n] = ((mode == 1) ? x : om[bj][n]) * sg;
                        }
                        *(u32x4*)(O + base[bj] + row * rp) = pack8(y[0], y[1]);
                    }
                }
        }
    }
};

struct EpiRes {
    static constexpr bool PERM = true, MIDK = false;
    const float* base0; const float* base1; float* out; bf16_t* a2; float* ss;
    DI void operator()(const AccT& acc, const Unit& u, int wr, int wc, int fr, int fq) const {
        const int row0 = u.pm * 256 + wr * 64 + fr, col0 = u.pn * 256 + wc * 32 + 8 * fq;
        const float* base = u.pm < MH / 256 ? base0 : base1 - (size_t)MH * D;
#pragma unroll
        for (int ai = 0; ai < 2; ++ai)
#pragma unroll
            for (int m = 0; m < 4; ++m) {
                const size_t row = (size_t)(row0 + ai * 128 + m * 16);
                float s = 0.f;
#pragma unroll
                for (int bj = 0; bj < 2; ++bj) {
                    const float* bp = base + row * D + col0 + bj * 128;
                    const f32x4 h0 = *(const f32x4*)bp + acc[ai][bj][m][0], h1 = *(const f32x4*)(bp + 4) + acc[ai][bj][m][1];
                    *(u32x4*)(a2 + row * D + col0 + bj * 128) = pack8(h0, h1);
                    s += (h0[0] * h0[0] + h0[1] * h0[1]) + (h0[2] * h0[2] + h0[3] * h0[3]) + (h1[0] * h1[0] + h1[1] * h1[1]) + (h1[2] * h1[2] + h1[3] * h1[3]);
                }
                s += __shfl_xor(s, 16); s += __shfl_xor(s, 32);
                if (fq == 0) ss[row * 16 + u.pn * 4 + wc] = s;
            }
    }
};

template <int CTRL> DI float dpp_mov(float x) { return __builtin_bit_cast(float, __builtin_amdgcn_update_dpp(0, __builtin_bit_cast(int, x), CTRL, 0xf, 0xf, false)); }
template <int CTRL> DI f32x4 dpp4(const f32x4 x) { return (f32x4){dpp_mov<CTRL>(x[0]), dpp_mov<CTRL>(x[1]), dpp_mov<CTRL>(x[2]), dpp_mov<CTRL>(x[3])}; }
template <int CTRL> DI float dpp_movo(float old, float x) { return __builtin_bit_cast(float, __builtin_amdgcn_update_dpp(__builtin_bit_cast(int, old), __builtin_bit_cast(int, x), CTRL, 0xf, 0xf, false)); }
template <int CTRL> DI f32x4 dpp4o(const f32x4 o, const f32x4 x) { return (f32x4){dpp_movo<CTRL>(o[0], x[0]), dpp_movo<CTRL>(o[1], x[1]), dpp_movo<CTRL>(o[2], x[2]), dpp_movo<CTRL>(o[3], x[3])}; }
DI float gelu_tanh(float x) { const float z = 1.5957691216057308f * (x + 0.044715f * x * x * x); return x * sigm(z); }
DI f32x4 gelu_tanh4(f32x4 x) { const f32x4 t = (x + (x * x * x) * 0.044715f) * (-1.5957691216057308f * 1.4426950408889634f); return x * sig4_exp2(t); }
struct EpiFfn {
    static constexpr bool PERM = true, MIDK = false;
    const float* ss; const float* cw; const float* cb; bf16_t* G; float* SIDE; LAS float* HAL;
    DI void operator()(AccT& acc, const Unit& u, int wr, int wc, int fr, int fq) const {
        const int row0 = u.pm * 256 + wr * 64 + fr, c0 = wc * 32 + 8 * fq, f0 = u.pn * 128 + c0;
        LAS float* RSL = HAL + 1024;
        { const int t = opaque(threadIdx.x);
          if (t < 256) { const f32x4* sp = (const f32x4*)(ss + (size_t)(u.pm * 256 + t) * 16); const f32x4 s4 = (sp[0] + sp[1]) + (sp[2] + sp[3]);
                         RSL[t] = rsqrtf(((s4[0] + s4[1]) + (s4[2] + s4[3])) * (1.f / D) + EPS); } }
        asm volatile("s_waitcnt lgkmcnt(0)" ::: "memory"); __builtin_amdgcn_s_barrier(); asm volatile("" ::: "memory");
#pragma unroll
        for (int ai = 0; ai < 2; ++ai)
#pragma unroll
            for (int m = 0; m < 4; ++m) {
                const float rs = RSL[ai * 128 + wr * 64 + m * 16 + fr];
#pragma unroll
                for (int bj = 0; bj < 2; ++bj)
#pragma unroll
                    for (int n = 0; n < 2; ++n) acc[ai][bj][m][n] = acc[ai][bj][m][n] * rs;
            }
#pragma unroll
        for (int ai = 0; ai < 2; ++ai) {
            const int b = 2 * ai + wr;
            if (fr == 0) { *(LAS f32x4*)(HAL + (b * 2 + 0) * 128 + c0) = acc[ai][0][0][0]; *(LAS f32x4*)(HAL + (b * 2 + 0) * 128 + c0 + 4) = acc[ai][0][0][1]; }
            if (fr == 15) { *(LAS f32x4*)(HAL + (b * 2 + 1) * 128 + c0) = acc[ai][0][3][0]; *(LAS f32x4*)(HAL + (b * 2 + 1) * 128 + c0 + 4) = acc[ai][0][3][1]; }
        }
        asm volatile("s_waitcnt lgkmcnt(0)" ::: "memory"); __builtin_amdgcn_s_barrier(); asm volatile("" ::: "memory");
        f32x4 w0[2], w1[2], w2[2], bb[2];
#pragma unroll
        for (int n = 0; n < 2; ++n) { w0[n] = *(const f32x4*)(cw + f0 + 4 * n); w1[n] = *(const f32x4*)(cw + DFF + f0 + 4 * n); w2[n] = *(const f32x4*)(cw + 2 * DFF + f0 + 4 * n); bb[n] = *(const f32x4*)(cb + f0 + 4 * n); }
        const f32x4 zero4 = (f32x4){0.f, 0.f, 0.f, 0.f};
#pragma unroll
        for (int ai = 0; ai < 2; ++ai) {
            const int b = 2 * ai + wr;
            f32x4 ht[2], hb[2];
#pragma unroll
            for (int n = 0; n < 2; ++n) {
                ht[n] = b > 0 ? *(const LAS f32x4*)(HAL + ((b - 1) * 2 + 1) * 128 + c0 + 4 * n) : zero4;
                hb[n] = b < 3 ? *(const LAS f32x4*)(HAL + ((b + 1) * 2 + 0) * 128 + c0 + 4 * n) : zero4;
            }
#pragma unroll
            for (int m = 0; m < 4; ++m) {
                const size_t row = (size_t)(row0 + ai * 128 + m * 16);
                f32x4 x[2], y[2];
#pragma unroll
                for (int n = 0; n < 2; ++n) {
                    const f32x4 cur = acc[ai][0][m][n];
                    f32x4 altp, altn;
                    if (m > 0) altp = dpp4<0x121>(acc[ai][0][m > 0 ? m - 1 : 0][n]); else altp = ht[n];
                    if (m < 3) altn = dpp4<0x12F>(acc[ai][0][m < 3 ? m + 1 : 3][n]); else altn = hb[n];
                    const f32x4 up = dpp4o<0x111>(altp, cur), un = dpp4o<0x101>(altn, cur);
                    x[n] = bb[n] + w0[n] * up + w1[n] * cur + w2[n] * un;
                    y[n] = gelu_tanh4(x[n]) * acc[ai][1][m][n];
                }
                *(u32x4*)(G + row * DFF + f0) = pack8(y[0], y[1]);
                if (m == 0 && b == 0 && fr == 0) {
                    float* sd = SIDE + ((size_t)(u.pm * 2 + 0) * 3) * DFF + f0;
#pragma unroll
                    for (int n = 0; n < 2; ++n) { *(f32x4*)(sd + 4 * n) = x[n]; *(f32x4*)(sd + DFF + 4 * n) = acc[ai][0][m][n]; *(f32x4*)(sd + 2 * DFF + 4 * n) = acc[ai][1][m][n]; }
                }
                if (m == 3 && b == 3 && fr == 15) {
                    float* sd = SIDE + ((size_t)(u.pm * 2 + 1) * 3) * DFF + f0;
#pragma unroll
                    for (int n = 0; n < 2; ++n) { *(f32x4*)(sd + 4 * n) = x[n]; *(f32x4*)(sd + DFF + 4 * n) = acc[ai][0][m][n]; *(f32x4*)(sd + 2 * DFF + 4 * n) = acc[ai][1][m][n]; }
                }
            }
        }
    }
};
DI void ffn_fixup_phase(const float* __restrict__ SIDE, const float* __restrict__ cw, bf16_t* __restrict__ G, int gtid, int NT) {
    constexpr int NCH = DFF / 8;
    for (int idx = gtid; idx < (2 * MH / 256) * 2 * NCH; idx += NT) {
        const int ci = idx % NCH, pw = idx / NCH, which = pw & 1, pm = pw >> 1, f0 = 8 * ci;
        const int row = 256 * pm + (which ? 255 : 0), L = row < MH ? 2048 : 4096, pos = row & (L - 1);
        const float* sd = SIDE + ((size_t)(pm * 2 + which) * 3) * DFF + f0;
        const bool has = which ? (pos != L - 1) : (pos != 0);
        const float* nb = SIDE + ((size_t)((which ? pm + 1 : pm - 1) * 2 + (which ? 0 : 1)) * 3 + 1) * DFF + f0;
        const float* wg = cw + (which ? 2 * DFF : 0) + f0;
        f32x4 y[2];
#pragma unroll
        for (int n = 0; n < 2; ++n) {
            f32x4 x = *(const f32x4*)(sd + 4 * n); const f32x4 vv = *(const f32x4*)(sd + 2 * DFF + 4 * n);
            if (has) x = x + *(const f32x4*)(wg + 4 * n) * *(const f32x4*)(nb + 4 * n);
#pragma unroll
            for (int j = 0; j < 4; ++j) y[n][j] = gelu_tanh(x[j]) * vv[j];
        }
        *(u32x4*)(G + (size_t)row * DFF + f0) = pack8(y[0], y[1]);
    }
}


struct EpiFinal {
    static constexpr bool PERM = true, MIDK = false;
    const bf16_t* base; float* out; const float* wfin; float* xs; unsigned* cnt; LAS unsigned char* lx;
    DI void operator()(AccT& acc, const Unit& u, int wr, int wc, int fr, int fq) const {
        LAS float* PT = (LAS float*)lx; LAS float* ST = (LAS float*)(lx + 4096); volatile LAS unsigned* FL = (volatile LAS unsigned*)(lx + 4096 + 1024);
        const int row0 = u.pm * 256 + wr * 64 + fr, col0 = u.pn * 256 + wc * 32 + 8 * fq;
        const int tid = opaque(threadIdx.x), lane = tid & 63, wid = __builtin_amdgcn_readfirstlane(tid >> 6);
#pragma unroll
        for (int ai = 0; ai < 2; ++ai)
#pragma unroll
            for (int m = 0; m < 4; ++m) {
                const size_t row = (size_t)(row0 + ai * 128 + m * 16);
                float s = 0.f;
#pragma unroll
                for (int bj = 0; bj < 2; ++bj) {
                    f32x4 r0, r1; unpack8(*(const u32x4*)(base + row * D + col0 + bj * 128), r0, r1);
                    const f32x4 h0 = r0 + acc[ai][bj][m][0], h1 = r1 + acc[ai][bj][m][1];
                    acc[ai][bj][m][0] = h0; acc[ai][bj][m][1] = h1;
                    s += (h0[0] * h0[0] + h0[1] * h0[1]) + (h0[2] * h0[2] + h0[3] * h0[3]) + (h1[0] * h1[0] + h1[1] * h1[1]) + (h1[2] * h1[2] + h1[3] * h1[3]);
                }
                s += __shfl_xor(s, 16); s += __shfl_xor(s, 32);
                if (fq == 0) PT[(ai * 128 + wr * 64 + m * 16 + fr) * 4 + wc] = s;
            }
        asm volatile("s_waitcnt lgkmcnt(0)" ::: "memory"); __builtin_amdgcn_s_barrier(); asm volatile("" ::: "memory");
        const int prow = wid * 32 + (lane & 31);
        if (lane < 32) {
            const float tot = (PT[prow * 4 + 0] + PT[prow * 4 + 1]) + (PT[prow * 4 + 2] + PT[prow * 4 + 3]);
            __hip_atomic_store(xs + ((size_t)(u.pm * 256 + prow) * 4 + u.pn), tot, __ATOMIC_RELAXED, __HIP_MEMORY_SCOPE_AGENT);
        }
        asm volatile("s_waitcnt vmcnt(0)" ::: "memory");
        if (lane == 0) __hip_atomic_fetch_add(cnt + 64 * u.pm, 1u, __ATOMIC_RELAXED, __HIP_MEMORY_SCOPE_AGENT);
        if (wid == 0) {
            unsigned spins = 0;
            for (;;) {
                if ((unsigned)__builtin_amdgcn_readfirstlane(__hip_atomic_load(cnt + 64 * u.pm, __ATOMIC_RELAXED, __HIP_MEMORY_SCOPE_AGENT)) >= 32u) break;
                if (++spins > (1u << 22)) break;
                __builtin_amdgcn_s_sleep(2);
            }
            __builtin_amdgcn_fence(__ATOMIC_ACQUIRE, "agent");
            if (lane == 0) FL[0] = 1u;
        }
        asm volatile("s_waitcnt vmcnt(0) lgkmcnt(0)" ::: "memory"); __builtin_amdgcn_s_barrier(); asm volatile("" ::: "memory");
        if (lane < 32) {
            const float* sl = xs + (size_t)(u.pm * 256 + prow) * 4;
            const float t0 = __hip_atomic_load(sl + 0, __ATOMIC_RELAXED, __HIP_MEMORY_SCOPE_AGENT), t1 = __hip_atomic_load(sl + 1, __ATOMIC_RELAXED, __HIP_MEMORY_SCOPE_AGENT);
            const float t2 = __hip_atomic_load(sl + 2, __ATOMIC_RELAXED, __HIP_MEMORY_SCOPE_AGENT), t3 = __hip_atomic_load(sl + 3, __ATOMIC_RELAXED, __HIP_MEMORY_SCOPE_AGENT);
            ST[prow] = rsqrtf(((t0 + t1) + (t2 + t3)) * (1.f / D) + EPS);
        }
        asm volatile("s_waitcnt vmcnt(0) lgkmcnt(0)" ::: "memory"); __builtin_amdgcn_s_barrier(); asm volatile("" ::: "memory");
        f32x4 wv[2][2];
#pragma unroll
        for (int bj = 0; bj < 2; ++bj)
#pragma unroll
            for (int n = 0; n < 2; ++n) wv[bj][n] = *(const f32x4*)(wfin + col0 + bj * 128 + 4 * n);
#pragma unroll
        for (int ai = 0; ai < 2; ++ai)
#pragma unroll
            for (int m = 0; m < 4; ++m) {
                const int rl = ai * 128 + wr * 64 + m * 16 + fr; const float rs = ST[rl];
                float* op = out + (size_t)(u.pm * 256 + rl) * D + col0;
#pragma unroll
                for (int bj = 0; bj < 2; ++bj) { *(f32x4*)(op + bj * 128) = acc[ai][bj][m][0] * rs * wv[bj][0]; *(f32x4*)(op + bj * 128 + 4) = acc[ai][bj][m][1] * rs * wv[bj][1]; }
            }
    }
};


struct EpiMerge2 {
    static constexpr bool PERM = true, MIDK = true;
    const bf16_t* PJ; bf16_t* MG;
    DI void mid(AccT& acc, const Unit& u, int wr, int wc, int fr, int fq) const {
        fr = opaque(fr); fq = opaque(fq);
        const int row0 = u.pm * 256 + wr * 64 + fr, col0 = u.pn * 256 + wc * 32 + 8 * fq;
#pragma unroll
        for (int ai = 0; ai < 2; ++ai)
#pragma unroll
            for (int m = 0; m < 4; ++m) {
                const size_t row = (size_t)(row0 + ai * 128 + m * 16);
#pragma unroll
                for (int bj = 0; bj < 2; ++bj) {
                    f32x4 a0, a1, b0, b1;
                    unpack8(*(const u32x4*)(PJ + PJ_G0 + row * 2048 + col0 + bj * 128), a0, a1);
                    unpack8(*(const u32x4*)(PJ + PJ_G0 + row * 2048 + 1024 + col0 + bj * 128), b0, b1);
#pragma unroll
                    for (int j = 0; j < 4; ++j) { a0[j] *= __builtin_amdgcn_rcpf(fmaxf(b0[j], 1e-30f)); a1[j] *= __builtin_amdgcn_rcpf(fmaxf(b1[j], 1e-30f)); }
                    acc[ai][bj][m][0] = acc[ai][bj][m][0] * a0; acc[ai][bj][m][1] = acc[ai][bj][m][1] * a1;
                }
                asm volatile("" ::: "memory");
            }
    }
    DI void operator()(const AccT& acc, const Unit& u, int wr, int wc, int fr, int fq) const {
        const int row0 = u.pm * 256 + wr * 64 + fr, col0 = u.pn * 256 + wc * 32 + 8 * fq;
#pragma unroll
        for (int ai = 0; ai < 2; ++ai)
#pragma unroll
            for (int m = 0; m < 4; ++m) {
                const size_t row = (size_t)(row0 + ai * 128 + m * 16);
#pragma unroll
                for (int bj = 0; bj < 2; ++bj) {
                    f32x4 b0, b1; unpack8(*(const u32x4*)(PJ + PJ_G0 + row * 2048 + 1024 + col0 + bj * 128), b0, b1);
#pragma unroll
                    for (int j = 0; j < 4; ++j) { b0[j] = fmaxf(b0[j], 1e-30f); b1[j] = fmaxf(b1[j], 1e-30f); }
                    *(u32x4*)(MG + row * D + col0 + bj * 128) = pack8(acc[ai][bj][m][0] * b0, acc[ai][bj][m][1] * b1);
                }
            }
    }
};

template <int MAP> DI int src_col(int p) {
    if (MAP == 1) { if (p < 1024) { const int w = p & 63; const int d = 32 * ((w >> 2) & 1) + 16 * (w >> 5) + 4 * ((w >> 3) & 3) + (w & 3); return (p & ~63) + d; } return p; }
    if (MAP == 2) { const int j = p >> 8, hf = (p >> 7) & 1, c = p & 127; return hf * DFF + 128 * j + c; }
    return p;
}
template <int MAP> DI void p0_item(const float* __restrict__ W, int K, int Nsrc, bf16_t* __restrict__ WT, const float* __restrict__ ks, LAS float* scr, int item, int nblk, int lane, int ldw = 0, int koff = 0) {
    if (ldw == 0) ldw = K;
    const int kb = item / nblk, nb = item % nblk, k0 = 64 * kb, n0 = 32 * nb;
    const int sc = src_col<MAP>(n0 + (lane & 31));
#pragma unroll 8
    for (int i = 0; i < 32; ++i) { const int kk = 2 * i + (lane >> 5); float v = W[(size_t)(k0 + kk) * Nsrc + sc]; if (ks) v *= ks[k0 + kk]; scr[kk * 33 + (lane & 31)] = v; }
    asm volatile("s_waitcnt lgkmcnt(0)" ::: "memory");
    const int c = lane & 7;
#pragma unroll
    for (int j = 0; j < 4; ++j) { const int n = (lane >> 3) + 8 * j; const LAS float* s = scr + (8 * c) * 33 + n;
        u32x4 o; o.x = pk2(s[0 * 33], s[1 * 33]); o.y = pk2(s[2 * 33], s[3 * 33]); o.z = pk2(s[4 * 33], s[5 * 33]); o.w = pk2(s[6 * 33], s[7 * 33]);
        *(u32x4*)(WT + (size_t)(n0 + n) * ldw + koff + k0 + 8 * c) = o; }
    asm volatile("s_waitcnt lgkmcnt(0)" ::: "memory");
}
DI void rms_row_bf16(const float* __restrict__ xrow, const float* __restrict__ w, bf16_t* __restrict__ orow, int lane) {
    const f32x4* xr = (const f32x4*)xrow + lane; f32x4 v[4]; float s = 0.f;
#pragma unroll
    for (int j = 0; j < 4; ++j) { v[j] = xr[64 * j]; s += (v[j][0] * v[j][0] + v[j][1] * v[j][1]) + (v[j][2] * v[j][2] + v[j][3] * v[j][3]); }
    const float rs = rsqrtf(wave_sum(s) * (1.f / D) + EPS);
    u32x2* o8 = (u32x2*)orow + lane;
#pragma unroll
    for (int j = 0; j < 4; ++j) { const f32x4 wv = ((const f32x4*)w)[lane + 64 * j]; const f32x4 y = v[j] * rs * wv; u32x2 o; o.x = pk2(y[0], y[1]); o.y = pk2(y[2], y[3]); o8[64 * j] = o; }
}

constexpr int HGP = 136;
constexpr int RTP = 72;
typedef short s16x4 __attribute__((ext_vector_type(4)));
#ifndef MK_NO_TR
DI bf16x8 ld_tr(const LAS bf16_t* t, int pitch, int row0, int col, int lane) {
    const int r = lane & 15, qq = r >> 2, p = r & 3;
    LAS bf16_t* a = (LAS bf16_t*)t + (row0 + qq) * pitch + (col - r) + 4 * p;
    const s16x4 lo = __builtin_amdgcn_ds_read_tr16_b64_v4i16((LAS s16x4*)a);
    const s16x4 hi = __builtin_amdgcn_ds_read_tr16_b64_v4i16((LAS s16x4*)(a + 4 * pitch));
    return __builtin_shufflevector(lo, hi, 0, 1, 2, 3, 4, 5, 6, 7);
}
#else
DI bf16x8 ld_tr(const LAS bf16_t* t, int pitch, int row0, int col, int lane) {
    bf16x8 v;
#pragma unroll
    for (int e = 0; e < 8; ++e) v[e] = (short)t[(row0 + e) * pitch + col];
    return v;
}
#endif
DI bf16x8 ld_row(const LAS bf16_t* t, int pitch, int row, int col0) { return *(const LAS bf16x8*)(t + row * pitch + col0); }
DI void st4bf(LAS bf16_t* p, float a, float b, float c, float d) { u32x2 w; w.x = pk2(a, b); w.y = pk2(c, d); *(LAS u32x2*)p = w; }

DI void hg_gates(LAS bf16_t* KF, LAS bf16_t* KB, LAS bf16_t* QF, LAS bf16_t* QB, LAS float* SEG, const bool withq, int tid) {
    const int dir = tid >> 8, seg = __builtin_amdgcn_readfirstlane((tid >> 6) & 3), dp = tid & 63;
    LAS unsigned* Kt = (LAS unsigned*)(dir ? KB : KF); LAS unsigned* Qt = (LAS unsigned*)(dir ? QB : QF);
    constexpr int WP = HGP / 2;
    float p0 = 1.f, p1 = 1.f;
#pragma unroll
    for (int s = 0; s < 16; ++s) { const int t = dir ? (16 * seg + 15 - s) : (16 * seg + s); const unsigned w = Kt[t * WP + dp]; p0 *= 1.f - bflo(w); p1 *= 1.f - bfhi(w); }
    SEG[(dir * 4 + seg) * 128 + 2 * dp] = p0; SEG[(dir * 4 + seg) * 128 + 2 * dp + 1] = p1;
    __syncthreads();
    float P0 = 1.f, P1 = 1.f;
#pragma unroll
    for (int s2 = 0; s2 < 4; ++s2) { const bool before = dir ? (s2 > seg) : (s2 < seg); if (before) { P0 *= SEG[(dir * 4 + s2) * 128 + 2 * dp]; P1 *= SEG[(dir * 4 + s2) * 128 + 2 * dp + 1]; } }
#pragma unroll
    for (int s = 0; s < 16; ++s) {
        const int t = dir ? (16 * seg + 15 - s) : (16 * seg + s);
        const unsigned w = Kt[t * WP + dp]; const float k0 = bflo(w), k1 = bfhi(w);
        P0 *= 1.f - k0; P1 *= 1.f - k1;
        Kt[t * WP + dp] = pk2(k0 * __builtin_amdgcn_rcpf(fmaxf(P0, 1e-30f)), k1 * __builtin_amdgcn_rcpf(fmaxf(P1, 1e-30f)));
        if (withq) { const unsigned qw = Qt[t * WP + dp]; Qt[t * WP + dp] = pk2(bflo(qw) * P0, bfhi(qw) * P1); }
    }
    __syncthreads();
}
DI float hg_seg_total(const LAS float* SEG, int dir, int d) { return (SEG[(dir * 4 + 0) * 128 + d] * SEG[(dir * 4 + 1) * 128 + d]) * (SEG[(dir * 4 + 2) * 128 + d] * SEG[(dir * 4 + 3) * 128 + d]); }

DI void hgs_fetch(u32x4 (&R)[6], const bf16_t* __restrict__ PJ, int item, int tid) {
    const int h = item & 3; const size_t toff = (size_t)(item >> 2) * 64 * 128;
#pragma unroll
    for (int j = 0; j < 2; ++j) { const size_t o = toff + 8 * (size_t)(tid + NTHREADS * j);
        R[j] = *(const u32x4*)(PJ + pj_hg(1, h) + o); R[2 + j] = *(const u32x4*)(PJ + pj_hg(2, h) + o); R[4 + j] = *(const u32x4*)(PJ + pj_hg(3, h) + o); }
}
DI void hgo_fetch(u32x4 (&R)[8], const bf16_t* __restrict__ PJ, int item, int tid) {
    const int h = item & 3; const size_t toff = (size_t)(item >> 2) * 64 * 128;
#pragma unroll
    for (int j = 0; j < 2; ++j) { const size_t o = toff + 8 * (size_t)(tid + NTHREADS * j);
        R[j] = *(const u32x4*)(PJ + pj_hg(0, h) + o); R[2 + j] = *(const u32x4*)(PJ + pj_hg(1, h) + o); R[4 + j] = *(const u32x4*)(PJ + pj_hg(2, h) + o); R[6 + j] = *(const u32x4*)(PJ + pj_hg(3, h) + o); }
}
DI void rts_fetch(u32x4 (&R)[4], const bf16_t* __restrict__ PJ, int item, int tid) {
    const int h = item & 7; const size_t toff = (size_t)(item >> 3) * 128 * 64;
#pragma unroll
    for (int j = 0; j < 2; ++j) { const size_t o = toff + 8 * (size_t)(tid + NTHREADS * j);
        R[j] = *(const u32x4*)(PJ + pj_ret(1, h) + o); R[2 + j] = *(const u32x4*)(PJ + pj_ret(2, h) + o); }
}
DI void rto_fetch(u32x4 (&R)[6], const bf16_t* __restrict__ PJ, int item, int tid) {
    const int h = item & 7; const size_t toff = (size_t)(item >> 3) * 128 * 64;
#pragma unroll
    for (int j = 0; j < 2; ++j) { const size_t o = toff + 8 * (size_t)(tid + NTHREADS * j);
        R[j] = *(const u32x4*)(PJ + pj_ret(0, h) + o); R[2 + j] = *(const u32x4*)(PJ + pj_ret(1, h) + o); R[4 + j] = *(const u32x4*)(PJ + pj_ret(2, h) + o); }
}

DI void hg_state_item(LAS unsigned char* lds, const bf16_t* __restrict__ PJ, bf16_t* __restrict__ dS, float* __restrict__ HE, int item, int next, u32x4 (&R)[6], int tid, int lane, int wid) {
    LAS bf16_t* KF = (LAS bf16_t*)lds; LAS bf16_t* KB = KF + 64 * HGP; LAS bf16_t* V = KB + 64 * HGP; LAS float* SEG = (LAS float*)(V + 64 * HGP);
#pragma unroll
    for (int j = 0; j < 2; ++j) { const int i = tid + NTHREADS * j; const int off = (i >> 4) * HGP + 8 * (i & 15);
        *(LAS u32x4*)(KF + off) = R[j]; *(LAS u32x4*)(KB + off) = R[2 + j]; *(LAS u32x4*)(V + off) = R[4 + j]; }
    __syncthreads();
    if (next >= 0) hgs_fetch(R, PJ, next, tid);
    hg_gates(KF, KB, nullptr, nullptr, SEG, false, tid);
    if (tid < 256) { const int dr = tid >> 7, d = tid & 127; HE[((size_t)item * 2 + dr) * 128 + d] = hg_seg_total(SEG, dr, d); }
    const int dir = wid >> 2, wq = wid & 3, r = lane & 15, q = lane >> 4;
    const LAS bf16_t* Kt = dir ? KB : KF;
    f32x4 acc[2][8];
#pragma unroll
    for (int mt = 0; mt < 2; ++mt)
#pragma unroll
        for (int nt = 0; nt < 8; ++nt) acc[mt][nt] = (f32x4){0.f, 0.f, 0.f, 0.f};
#pragma unroll
    for (int ks = 0; ks < 2; ++ks) {
        bf16x8 A[2];
#pragma unroll
        for (int mt = 0; mt < 2; ++mt) A[mt] = ld_tr(Kt, HGP, 32 * ks + 8 * q, 32 * wq + 16 * mt + r, lane);
#pragma unroll
        for (int nt = 0; nt < 8; ++nt) { const bf16x8 B = ld_tr(V, HGP, 32 * ks + 8 * q, 16 * nt + r, lane);
#pragma unroll
            for (int mt = 0; mt < 2; ++mt) acc[mt][nt] = MFMA16(A[mt], B, acc[mt][nt]); }
    }
    LAS bf16_t* STG = (LAS bf16_t*)(lds + 57344);
#pragma unroll
    for (int mt = 0; mt < 2; ++mt) {
        const int dk0 = 32 * wq + 16 * mt + 4 * q; f32x4 e;
#pragma unroll
        for (int jj = 0; jj < 4; ++jj) e[jj] = hg_seg_total(SEG, dir, dk0 + jj);
#pragma unroll
        for (int nt = 0; nt < 8; ++nt) { const int dv = 16 * nt + r; const f32x4 v = acc[mt][nt] * e; st4bf(STG + (dir * 128 + dv) * HGP + dk0, v[0], v[1], v[2], v[3]); }
    }
    __syncthreads();
    {
        bf16_t* dst = dS + (size_t)item * 2 * 128 * 128;
#pragma unroll
        for (int k = 0; k < 8; ++k) { const int ch = tid + NTHREADS * k; const int rowi = ch >> 4, c16 = ch & 15;
            *(u32x4*)(dst + (size_t)rowi * 128 + 8 * c16) = *(const LAS u32x4*)(STG + rowi * HGP + 8 * c16); }
    }
    __syncthreads();
}

DI void hg_out_item(LAS unsigned char* lds, const bf16_t* __restrict__ PJ, const bf16_t* __restrict__ HST, const float* __restrict__ wn, bf16_t* __restrict__ HGO, int item, int next, u32x4 (&R)[8], int tid, int lane, int wid) {
    const int c = item >> 2, h = item & 3; const size_t t0 = (size_t)c * 64;
    LAS bf16_t* QF = (LAS bf16_t*)lds; LAS bf16_t* QB = QF + 64 * HGP; LAS bf16_t* KF = QB + 64 * HGP; LAS bf16_t* KB = KF + 64 * HGP; LAS bf16_t* V = KB + 64 * HGP;
    LAS bf16_t* PF = V + 64 * HGP; LAS bf16_t* PB = PF + 64 * RTP; LAS float* SEG = (LAS float*)(PB + 64 * RTP);
#pragma unroll
    for (int j = 0; j < 2; ++j) { const int i = tid + NTHREADS * j; const int off = (i >> 4) * HGP + 8 * (i & 15);
        *(LAS u32x4*)(QF + off) = R[j]; *(LAS u32x4*)(QB + off) = R[j]; *(LAS u32x4*)(KF + off) = R[2 + j]; *(LAS u32x4*)(KB + off) = R[4 + j]; *(LAS u32x4*)(V + off) = R[6 + j]; }
    __syncthreads();
    if (next >= 0) hgo_fetch(R, PJ, next, tid);
    const int dir = wid >> 2, w4 = wid & 3, r = lane & 15, q = lane >> 4;
    bf16x8 SB[2][4];
#pragma unroll
    for (int dr = 0; dr < 2; ++dr) { const bf16_t* st = HST + ((size_t)item * 2 + dr) * 128 * 128;
#pragma unroll
      for (int ks = 0; ks < 4; ++ks) SB[dr][ks] = *(const bf16x8*)(st + (size_t)(16 * wid + r) * 128 + 32 * ks + 8 * q); }
    hg_gates(KF, KB, QF, QB, SEG, true, tid);
    const LAS bf16_t* Kt = dir ? KB : KF; const LAS bf16_t* Qt = dir ? QB : QF; LAS bf16_t* Pt = dir ? PB : PF;
    {
        f32x4 sc[4];
#pragma unroll
        for (int it = 0; it < 4; ++it) sc[it] = (f32x4){0.f, 0.f, 0.f, 0.f};
#pragma unroll
        for (int ks = 0; ks < 4; ++ks) { const bf16x8 A = ld_row(Kt, HGP, 16 * w4 + r, 32 * ks + 8 * q);
#pragma unroll
            for (int it = 0; it < 4; ++it) { const bf16x8 B = ld_row(Qt, HGP, 16 * it + r, 32 * ks + 8 * q); sc[it] = MFMA16(A, B, sc[it]); } }
#pragma unroll
        for (int it = 0; it < 4; ++it) { const int i = 16 * it + r; float v[4];
#pragma unroll
            for (int jj = 0; jj < 4; ++jj) { const int j = 16 * w4 + 4 * q + jj; const bool keep = dir ? (j >= i) : (j <= i); v[jj] = keep ? sc[it][jj] : 0.f; }
            st4bf(Pt + i * RTP + 16 * w4 + 4 * q, v[0], v[1], v[2], v[3]); }
    }
    __syncthreads();
    f32x4 o[4];
#pragma unroll
    for (int it = 0; it < 4; ++it) o[it] = (f32x4){0.f, 0.f, 0.f, 0.f};
#pragma unroll
    for (int ks = 0; ks < 2; ++ks) {
        const bf16x8 B = ld_tr(V, HGP, 32 * ks + 8 * q, 16 * wid + r, lane);
#pragma unroll
        for (int it = 0; it < 4; ++it) { const bf16x8 Af = ld_row(PF, RTP, 16 * it + r, 32 * ks + 8 * q), Ab = ld_row(PB, RTP, 16 * it + r, 32 * ks + 8 * q);
            o[it] = MFMA16(Af, B, o[it]); o[it] = MFMA16(Ab, B, o[it]); }
    }
#pragma unroll
    for (int dr = 0; dr < 2; ++dr) { const LAS bf16_t* Qd = dr ? QB : QF;
#pragma unroll
        for (int ks = 0; ks < 4; ++ks) {
#pragma unroll
            for (int it = 0; it < 4; ++it) { const bf16x8 A = ld_row(Qd, HGP, 16 * it + r, 32 * ks + 8 * q); o[it] = MFMA16(A, SB[dr][ks], o[it]); } } }
    const int fi = tid >> 3, fcc = tid & 7;
    const bf16_t* gp = PJ + pj_hg(4, h) + (t0 + fi) * 128 + 16 * fcc;
    const u32x4 gw0 = *(const u32x4*)gp, gw1 = *(const u32x4*)(gp + 8);
    __syncthreads();
    LAS float* OX = (LAS float*)lds;
#pragma unroll
    for (int it = 0; it < 4; ++it)
#pragma unroll
        for (int jj = 0; jj < 4; ++jj) OX[(16 * it + 4 * q + jj) * 132 + 16 * wid + r] = o[it][jj];
    __syncthreads();
    {
        const LAS f32x4* op = (const LAS f32x4*)(OX + fi * 132 + 16 * fcc);
        f32x4 v[4]; float ss = 0.f;
#pragma unroll
        for (int k = 0; k < 4; ++k) { v[k] = op[k]; ss += (v[k][0] * v[k][0] + v[k][1] * v[k][1]) + (v[k][2] * v[k][2] + v[k][3] * v[k][3]); }
        ss += __shfl_xor(ss, 1); ss += __shfl_xor(ss, 2); ss += __shfl_xor(ss, 4);
        const float rs = rsqrtf(ss * (1.f / 128.f) + EPS);
        const float* wp = wn + 128 * h + 16 * fcc;
        bf16_t* outp = HGO + (t0 + fi) * 1024 + 512 + 128 * h + 16 * fcc;
#pragma unroll
        for (int hh = 0; hh < 2; ++hh) {
            f32x4 g0, g1; unpack8(hh ? gw1 : gw0, g0, g1);
            const f32x4 w0 = *(const f32x4*)(wp + 8 * hh), w1 = *(const f32x4*)(wp + 8 * hh + 4);
            *(u32x4*)(outp + 8 * hh) = pack8(v[2 * hh] * rs * w0 * g0, v[2 * hh + 1] * rs * w1 * g1);
        }
    }
    __syncthreads();
}

DI void ret_state_item(LAS unsigned char* lds, const bf16_t* __restrict__ PJ, bf16_t* __restrict__ RS, int item, int next, u32x4 (&R)[4], int tid, int lane, int wid) {
    const int h = item & 7; const float lg = lg2gamma(h);
    LAS bf16_t* KF = (LAS bf16_t*)lds; LAS bf16_t* KB = KF + 128 * RTP; LAS bf16_t* V = KB + 128 * RTP;
#pragma unroll
    for (int j = 0; j < 2; ++j) { const int i = tid + NTHREADS * j; const int row = i >> 3, ch = i & 7;
        f32x4 a, b; unpack8(R[j], a, b);
        const float wf = __builtin_amdgcn_exp2f((float)(127 - row) * lg), wb = __builtin_amdgcn_exp2f((float)row * lg);
        *(LAS u32x4*)(KF + row * RTP + 8 * ch) = pack8(a * wf, b * wf); *(LAS u32x4*)(KB + row * RTP + 8 * ch) = pack8(a * wb, b * wb);
        *(LAS u32x4*)(V + row * RTP + 8 * ch) = R[2 + j]; }
    __syncthreads();
    if (next >= 0) rts_fetch(R, PJ, next, tid);
    const int dkt = wid & 3, dvh = wid >> 2, r = lane & 15, q = lane >> 4;
    f32x4 acc[2][2];
#pragma unroll
    for (int a = 0; a < 2; ++a)
#pragma unroll
        for (int b = 0; b < 2; ++b) acc[a][b] = (f32x4){0.f, 0.f, 0.f, 0.f};
#pragma unroll
    for (int ks = 0; ks < 4; ++ks) {
        const bf16x8 Af = ld_tr(KF, RTP, 32 * ks + 8 * q, 16 * dkt + r, lane), Ab = ld_tr(KB, RTP, 32 * ks + 8 * q, 16 * dkt + r, lane);
#pragma unroll
        for (int nt = 0; nt < 2; ++nt) { const bf16x8 B = ld_tr(V, RTP, 32 * ks + 8 * q, 32 * dvh + 16 * nt + r, lane);
            acc[0][nt] = MFMA16(Af, B, acc[0][nt]); acc[1][nt] = MFMA16(Ab, B, acc[1][nt]); }
    }
#pragma unroll
    for (int dr = 0; dr < 2; ++dr)
#pragma unroll
        for (int nt = 0; nt < 2; ++nt) { const int dv = 32 * dvh + 16 * nt + r, dk0 = 16 * dkt + 4 * q; const f32x4 v = acc[dr][nt]; u32x2 w; w.x = pk2(v[0], v[1]); w.y = pk2(v[2], v[3]);
            *(u32x2*)(RS + (((size_t)item * 2 + dr) * 64 + dv) * 64 + dk0) = w; }
    __syncthreads();
}

DI void ret_out_item(LAS unsigned char* lds, const bf16_t* __restrict__ PJ, const bf16_t* __restrict__ RST, const float* __restrict__ wn, bf16_t* __restrict__ RET, int item, int next, u32x4 (&R)[6], int tid, int lane, int wid) {
    const int c = item >> 3, h = item & 7; const size_t t0 = (size_t)c * 128; const float lg = lg2gamma(h);
    LAS bf16_t* Q = (LAS bf16_t*)lds; LAS bf16_t* QF = Q + 128 * RTP; LAS bf16_t* QB = QF + 128 * RTP; LAS bf16_t* K = QB + 128 * RTP; LAS bf16_t* V = K + 128 * RTP; LAS bf16_t* P = V + 128 * RTP;
#pragma unroll
    for (int j = 0; j < 2; ++j) { const int i = tid + NTHREADS * j; const int row = i >> 3, ch = i & 7;
        f32x4 a, b; unpack8(R[j], a, b);
        const float wf = __builtin_amdgcn_exp2f((float)(row + 1) * lg), wb = __builtin_amdgcn_exp2f((float)(128 - row) * lg);
        *(LAS u32x4*)(Q + row * RTP + 8 * ch) = R[j];
        *(LAS u32x4*)(QF + row * RTP + 8 * ch) = pack8(a * wf, b * wf); *(LAS u32x4*)(QB + row * RTP + 8 * ch) = pack8(a * wb, b * wb);
        *(LAS u32x4*)(K + row * RTP + 8 * ch) = R[2 + j]; *(LAS u32x4*)(V + row * RTP + 8 * ch) = R[4 + j]; }
    __syncthreads();
    if (next >= 0) rto_fetch(R, PJ, next, tid);
    const int r = lane & 15, q = lane >> 4;
    const int ih = wid >> 2, dvt = wid & 3;
    bf16x8 SB[2][2];
#pragma unroll
    for (int dr = 0; dr < 2; ++dr) { const bf16_t* st = RST + ((size_t)item * 2 + dr) * 64 * 64;
#pragma unroll
        for (int ks = 0; ks < 2; ++ks) SB[dr][ks] = *(const bf16x8*)(st + (size_t)(16 * dvt + r) * 64 + 32 * ks + 8 * q); }
    {
        f32x4 s[8];
#pragma unroll
        for (int it = 0; it < 8; ++it) s[it] = (f32x4){0.f, 0.f, 0.f, 0.f};
#pragma unroll
        for (int ks = 0; ks < 2; ++ks) { const bf16x8 A = ld_row(K, RTP, 16 * wid + r, 32 * ks + 8 * q);
#pragma unroll
            for (int it = 0; it < 8; ++it) { const bf16x8 B = ld_row(Q, RTP, 16 * it + r, 32 * ks + 8 * q); s[it] = MFMA16(A, B, s[it]); } }
#pragma unroll
        for (int it = 0; it < 8; ++it) { const int i = 16 * it + r; float v[4];
#pragma unroll
            for (int jj = 0; jj < 4; ++jj) { const int j = 16 * wid + 4 * q + jj; const int dd = i > j ? i - j : j - i; v[jj] = s[it][jj] * __builtin_amdgcn_exp2f((float)dd * lg); }
            st4bf(P + i * HGP + 16 * wid + 4 * q, v[0], v[1], v[2], v[3]); }
    }
    __syncthreads();
    f32x4 o[4];
#pragma unroll
    for (int it = 0; it < 4; ++it) o[it] = (f32x4){0.f, 0.f, 0.f, 0.f};
#pragma unroll
    for (int ks = 0; ks < 4; ++ks) { const bf16x8 B = ld_tr(V, RTP, 32 * ks + 8 * q, 16 * dvt + r, lane);
#pragma unroll
        for (int it = 0; it < 4; ++it) { const bf16x8 A = ld_row(P, HGP, 64 * ih + 16 * it + r, 32 * ks + 8 * q); o[it] = MFMA16(A, B, o[it]); } }
#pragma unroll
    for (int dr = 0; dr < 2; ++dr) { const LAS bf16_t* Qd = dr ? QB : QF;
#pragma unroll
        for (int ks = 0; ks < 2; ++ks) {
#pragma unroll
            for (int it = 0; it < 4; ++it) { const bf16x8 A = ld_row(Qd, RTP, 64 * ih + 16 * it + r, 32 * ks + 8 * q); o[it] = MFMA16(A, SB[dr][ks], o[it]); } } }
    const int fi = tid >> 2, fcc = tid & 3;
    const bf16_t* gp = PJ + pj_ret(3, h) + (t0 + fi) * 64 + 16 * fcc;
    const u32x4 gw0 = *(const u32x4*)gp, gw1 = *(const u32x4*)(gp + 8);
    __syncthreads();
    LAS float* OX = (LAS float*)lds;
#pragma unroll
    for (int it = 0; it < 4; ++it)
#pragma unroll
        for (int jj = 0; jj < 4; ++jj) OX[(64 * ih + 16 * it + 4 * q + jj) * 68 + 16 * dvt + r] = o[it][jj];
    __syncthreads();
    {
        const LAS f32x4* op = (const LAS f32x4*)(OX + fi * 68 + 16 * fcc);
        f32x4 v[4]; float ss = 0.f;
#pragma unroll
        for (int k = 0; k < 4; ++k) { v[k] = op[k]; ss += (v[k][0] * v[k][0] + v[k][1] * v[k][1]) + (v[k][2] * v[k][2] + v[k][3] * v[k][3]); }
        ss += __shfl_xor(ss, 1); ss += __shfl_xor(ss, 2);
        const float rs = rsqrtf(ss * (1.f / 64.f) + EPS);
        const float* wp = wn + 64 * h + 16 * fcc;
        bf16_t* outp = RET + (t0 + fi) * 1024 + 64 * h + 16 * fcc;
#pragma unroll
        for (int hh = 0; hh < 2; ++hh) {
            f32x4 g0, g1; unpack8(hh ? gw1 : gw0, g0, g1);
            const f32x4 w0 = *(const f32x4*)(wp + 8 * hh), w1 = *(const f32x4*)(wp + 8 * hh + 4);
            *(u32x4*)(outp + 8 * hh) = pack8(v[2 * hh] * rs * w0 * g0, v[2 * hh + 1] * rs * w1 * g1);
        }
    }
    __syncthreads();
}

DI void scan_phase(const bf16_t* __restrict__ dS, const float* __restrict__ HE, bf16_t* __restrict__ HST, const bf16_t* __restrict__ RSraw, bf16_t* __restrict__ RST, int nseq, int L, int gtid, int NT) {
    {
        const int NC = L / 64;
        for (int v = gtid; v < nseq * 16384; v += NT) {
            const int e = v & 2047, sd = v >> 11, dir = sd & 1, h = (sd >> 1) & 3, seq = sd >> 3, dv = e >> 4, dk8 = (e & 15) * 8;
            f32x4 S0 = (f32x4){0.f, 0.f, 0.f, 0.f}, S1 = S0;
            for (int n0 = 0; n0 < NC; n0 += 8) {
                u32x4 raw[8]; f32x4 e0[8], e1[8];
#pragma unroll
                for (int k = 0; k < 8; ++k) { const int nn = dir ? NC - 1 - (n0 + k) : n0 + k; const size_t it2 = ((size_t)(seq * NC + nn) * 4 + h) * 2 + dir;
                    raw[k] = *(const u32x4*)(dS + (it2 * 128 + dv) * 128 + dk8); e0[k] = *(const f32x4*)(HE + it2 * 128 + dk8); e1[k] = *(const f32x4*)(HE + it2 * 128 + dk8 + 4); }
#pragma unroll
                for (int k = 0; k < 8; ++k) { const int nn = dir ? NC - 1 - (n0 + k) : n0 + k; const size_t it2 = ((size_t)(seq * NC + nn) * 4 + h) * 2 + dir;
                    f32x4 a, b; unpack8(raw[k], a, b);
                    *(u32x4*)(HST + (it2 * 128 + dv) * 128 + dk8) = pack8(S0, S1);
                    S0 = e0[k] * S0 + a; S1 = e1[k] * S1 + b; }
            }
        }
    }
    {
        const int NC = L / 128;
        for (int v = gtid; v < nseq * 8192; v += NT) {
            const int e = v & 511, sd = v >> 9, dir = sd & 1, h = (sd >> 1) & 7, seq = sd >> 4, dv = e >> 3, dk8 = (e & 7) * 8;
            const float dec = __builtin_amdgcn_exp2f(128.f * lg2gamma(h));
            f32x4 S0 = (f32x4){0.f, 0.f, 0.f, 0.f}, S1 = S0;
            for (int n0 = 0; n0 < NC; n0 += 8) {
                u32x4 raw[8];
#pragma unroll
                for (int k = 0; k < 8; ++k) { const int nn = dir ? NC - 1 - (n0 + k) : n0 + k; const size_t it2 = ((size_t)(seq * NC + nn) * 8 + h) * 2 + dir;
                    raw[k] = *(const u32x4*)(RSraw + (it2 * 64 + dv) * 64 + dk8); }
#pragma unroll
                for (int k = 0; k < 8; ++k) { const int nn = dir ? NC - 1 - (n0 + k) : n0 + k; const size_t it2 = ((size_t)(seq * NC + nn) * 8 + h) * 2 + dir;
                    f32x4 a, b; unpack8(raw[k], a, b);
                    *(u32x4*)(RST + (it2 * 64 + dv) * 64 + dk8) = pack8(S0, S1);
                    S0 = S0 * dec + a; S1 = S1 * dec + b; }
            }
        }
    }
}

#define XB_TMO      128
#define XB_XCNT(j)  (256  + 64 * (j))
#define XB_XSUB(j)  (1280 + 64 * (j))
#define XB_XGEN(j)  (2304 + 64 * (j))
#define XB_TOP      3328
#define XB_TOPGEN   3392
#define XCD_BAR_WORDS 3456
#define XB_SPIN_CAP (1u << 18)
__device__ __forceinline__ unsigned xb_ld(unsigned* p)              { return __hip_atomic_load(p, __ATOMIC_RELAXED, __HIP_MEMORY_SCOPE_AGENT); }
__device__ __forceinline__ unsigned xb_add(unsigned* p, unsigned v) { return __hip_atomic_fetch_add(p, v, __ATOMIC_RELAXED, __HIP_MEMORY_SCOPE_AGENT); }
__device__ __forceinline__ unsigned xb_xcc_id() { return (unsigned)__builtin_amdgcn_s_getreg((3 << 11) | 20) & 0xFu; }
#define XB_SPIN(cond, bar) do { unsigned _sp = 0; while (cond) { __builtin_amdgcn_s_sleep(1); \
    if ((++_sp & 255u) == 0u) { if (xb_ld(&(bar)[XB_TMO])) break; if (_sp > XB_SPIN_CAP) { atomicAdd(&(bar)[XB_TMO], 1u); break; } } } } while (0)
struct XcdBarrier { unsigned* bar; unsigned x; volatile LAS unsigned* st; };
__device__ __forceinline__ XcdBarrier xcd_barrier_post(unsigned* bar, volatile LAS unsigned* st) {
    XcdBarrier b; b.bar = bar; b.x = xb_xcc_id(); b.st = st;
    if (threadIdx.x == 0) (void)xb_add(&bar[XB_XCNT(b.x)], 1u);
    return b;
}
__device__ __forceinline__ void xcd_barrier_complete(unsigned* bar, unsigned x, unsigned& nloc, unsigned& nx) {
    const unsigned G = gridDim.x * gridDim.y * gridDim.z;
    unsigned sum, cnt, mine, sp = 0u;
    for (;;) {
        sum = 0u; cnt = 0u; mine = 0u;
#pragma unroll
        for (unsigned j = 0; j < 16; ++j) { const unsigned c = xb_ld(&bar[XB_XCNT(j)]); sum += c; cnt += (c > 0u) ? 1u : 0u; mine = (j == x) ? c : mine; }
        if (sum == G) break;
        __builtin_amdgcn_s_sleep(1);
        if ((++sp & 255u) == 0u) { if (xb_ld(&bar[XB_TMO])) break; if (sp > XB_SPIN_CAP) { atomicAdd(&bar[XB_TMO], 1u); break; } }
    }
    nloc = mine > 0u ? mine : 1u; nx = cnt > 0u ? cnt : 1u;
}
__device__ __forceinline__ void xcd_barrier(const XcdBarrier& b) {
    asm volatile("s_waitcnt vmcnt(0)" ::: "memory");
    __syncthreads();
    if (threadIdx.x == 0) {
        unsigned* bar = b.bar;
        __builtin_amdgcn_s_waitcnt(0);
        unsigned nloc = b.st[0], nx = b.st[1];
        if (nloc == 0u) { xcd_barrier_complete(bar, b.x, nloc, nx); b.st[0] = nloc; b.st[1] = nx; }
        const unsigned old = xb_add(&bar[XB_XSUB(b.x)], 1u);
        const unsigned gen = old / nloc;
        if (old + 1u == (gen + 1u) * nloc) {
            __builtin_amdgcn_fence(__ATOMIC_RELEASE, "agent");
            asm volatile("s_waitcnt vmcnt(0)" ::: "memory");
            const unsigned og = xb_add(&bar[XB_TOP], 1u);
            const unsigned tg = og / nx;
            if (og + 1u == (tg + 1u) * nx) xb_add(&bar[XB_TOPGEN], 1u);
            else XB_SPIN(xb_ld(&bar[XB_TOPGEN]) == tg, bar);
            __builtin_amdgcn_fence(__ATOMIC_ACQUIRE, "agent");
            xb_add(&bar[XB_XGEN(b.x)], 1u);
            asm volatile("s_waitcnt vmcnt(0)" ::: "memory");
        } else {
            XB_SPIN(xb_ld(&bar[XB_XGEN(b.x)]) == gen, bar);
            __builtin_amdgcn_fence(__ATOMIC_ACQUIRE, "agent");
            asm volatile("s_waitcnt vmcnt(0)" ::: "memory");
        }
    }
    __syncthreads();
}
struct Args { const float* in[16]; float* out; unsigned char* ws; int lo, hi; };
constexpr int NPHASE = 15;

template <bool COOP>
__global__ void __launch_bounds__(NTHREADS) fwd(Args a) {
    extern __shared__ __attribute__((aligned(16))) unsigned char lds_raw[];
    LAS unsigned char* lds = (LAS unsigned char*)lds_raw;
    const int G = gridDim.x, bid = blockIdx.x;
    const int NT = G * NTHREADS, NGW = G * 8;
    unsigned char* ws = a.ws;
    float* OML = (float*)(ws + WS_OML); float* ROT = (float*)(ws + WS_ROT);
    bf16_t* WIN = (bf16_t*)(ws + WS_WIN); bf16_t* WR = (bf16_t*)(ws + WS_WR); bf16_t* WH = (bf16_t*)(ws + WS_WH); bf16_t* WO = (bf16_t*)(ws + WS_WO);
    bf16_t* WF = (bf16_t*)(ws + WS_WF); bf16_t* WD = (bf16_t*)(ws + WS_WD); bf16_t* HN = (bf16_t*)(ws + WS_HN);
    float* SS1 = (float*)(ws + WS_SS1); float* SS2 = (float*)(ws + WS_SS2); float* HE = (float*)(ws + WS_HE);
    bf16_t* RSRAW = (bf16_t*)(ws + WS_RSRAW); bf16_t* RST = (bf16_t*)(ws + WS_RST); bf16_t* HST = (bf16_t*)(ws + WS_HST);
    bf16_t* PJ = (bf16_t*)(ws + WS_PJ); bf16_t* GB = (bf16_t*)(ws + WS_G);
    bf16_t* RET = (bf16_t*)(ws + WS_RET); bf16_t* MG = (bf16_t*)(ws + WS_MG); bf16_t* A2 = (bf16_t*)(ws + WS_A2); float* SIDE = (float*)(ws + WS_SIDE);
    const int lo = a.lo, hi = a.hi;
    XcdBarrier xbar; xbar.bar = (unsigned*)(ws + WS_BAR); xbar.x = 0; xbar.st = nullptr;
    if (COOP) {
        volatile LAS unsigned* stw = (volatile LAS unsigned*)(lds + LDS_BARW);
        if (threadIdx.x < 2) stw[threadIdx.x] = 0u;
        __syncthreads();
        xbar = xcd_barrier_post((unsigned*)(ws + WS_BAR), stw);
    }
    int seq = 0;
#ifndef MK_MASK
#define MK_MASK 0xfff
#endif
#define PH_BEGIN(k) if (((MK_MASK >> (k)) & 1) && lo <= seq && seq < hi) { \
    const int tid = opaque(threadIdx.x), lane = tid & 63, wid = __builtin_amdgcn_readfirstlane(tid >> 6); \
    const int gtid = bid * NTHREADS + tid, gw = bid * 8 + wid; (void)lane; (void)gtid; (void)gw;
#define PH_END   if (COOP && seq + 1 < hi) { if (lo < 0) cg::this_grid().sync(); else xcd_barrier(xbar); } } ++seq;

    PH_BEGIN(0)
        LAS float* scr = (LAS float*)(lds + wid * 16384);
        constexpr int I_IN = 16 * 208, I_R = 8 * 32, I_H = 8 * 32, I_O = 16 * 32, I_F = 16 * 176, I_D = 44 * 32;
        constexpr int NIT = I_IN + I_R + I_H + I_O + I_F + I_D;
        for (int it = gw; it < NIT; it += NGW) {
            int r = it;
            if (r < I_IN) { p0_item<1>(a.in[2], 1024, DIN, WIN, nullptr, scr, r, 208, lane); continue; } r -= I_IN;
            if (r < I_R) { p0_item<0>(a.in[6], 512, 1024, WR, nullptr, scr, r, 32, lane, 1024, 0); continue; } r -= I_R;
            if (r < I_H) { p0_item<0>(a.in[7], 512, 1024, WR, nullptr, scr, r, 32, lane, 1024, 512); continue; } r -= I_H;
            if (r < I_O) { p0_item<0>(a.in[8], 1024, 1024, WO, nullptr, scr, r, 32, lane); continue; } r -= I_O;
            if (r < I_F) { p0_item<2>(a.in[11], 1024, NFF2, WF, a.in[10], scr, r, 176, lane); continue; } r -= I_F;
            p0_item<0>(a.in[14], DFF, 1024, WD, nullptr, scr, r, 32, lane);
        }
        for (int i = gtid; i < 4096 * 32; i += NT) {
            const int pos = i >> 5, fi = i & 31;
            const float invf = __builtin_amdgcn_exp2f(-(float)fi * 0.4152410118609203f);
            const float ang = (float)pos * invf;
            const double rev = (double)ang * 0.15915494309189535; const float fr = (float)(rev - floor(rev));
            ROT[i] = __builtin_amdgcn_cosf(fr); ROT[4096 * 32 + i] = __builtin_amdgcn_sinf(fr);
        }
        for (int i = gtid; i < 1024; i += NT) { const float l0 = a.in[3][i], l1 = a.in[3][1024 + i]; OML[i] = sigm(l1 - l0); }
        for (int m = gw; m < MH; m += NGW) {
            const f32x4* x0 = (const f32x4*)(a.in[0] + (size_t)m * D) + lane; const f32x4* x1 = (const f32x4*)(a.in[1] + (size_t)m * D) + lane;
            f32x4 v0[4], v1[4]; float s0 = 0.f, s1 = 0.f;
#pragma unroll
            for (int j = 0; j < 4; ++j) { v0[j] = x0[64 * j]; v1[j] = x1[64 * j]; }
#pragma unroll
            for (int j = 0; j < 4; ++j) { s0 += (v0[j][0] * v0[j][0] + v0[j][1] * v0[j][1]) + (v0[j][2] * v0[j][2] + v0[j][3] * v0[j][3]); s1 += (v1[j][0] * v1[j][0] + v1[j][1] * v1[j][1]) + (v1[j][2] * v1[j][2] + v1[j][3] * v1[j][3]); }
            const float r0 = rsqrtf(wave_sum(s0) * (1.f / D) + EPS), r1 = rsqrtf(wave_sum(s1) * (1.f / D) + EPS);
            u32x2* o0 = (u32x2*)(HN + (size_t)m * D) + lane; u32x2* o1 = (u32x2*)(HN + (size_t)(MH + m) * D) + lane;
#pragma unroll
            for (int j = 0; j < 4; ++j) { const f32x4 wv = ((const f32x4*)a.in[9])[lane + 64 * j]; const f32x4 y0 = v0[j] * r0 * wv, y1 = v1[j] * r1 * wv;
                u32x2 p0; p0.x = pk2(y0[0], y0[1]); p0.y = pk2(y0[2], y0[3]); o0[64 * j] = p0; u32x2 p1; p1.x = pk2(y1[0], y1[1]); p1.y = pk2(y1[2], y1[3]); o1[64 * j] = p1; }
        }
    PH_END

    for (int g = 0; g < 2; ++g) {
        const int L = g ? 4096 : 2048, nseq = g ? 8 : 16;
        const float* xin = a.in[g]; float* outh = a.out + (size_t)g * MH * D;
        bf16_t* DSRAW = (bf16_t*)outh;
        PH_BEGIN(1)
            pg8::Gemm gm{HN + (size_t)g * MH * D, WIN, MH, DIN, D}; pg8::StaticOrder S; S.init(MH, DIN, G, bid);
            EpiProj E{PJ, ROT, OML, L - 1};
            pg8::gemm_phase<EpiProj, pg8::StaticOrder, true, true>(lds, gm, S, E);
        PH_END
        PH_BEGIN(2)
            if (wid >= 4) __builtin_amdgcn_s_setprio(1);
            { u32x4 R[6]; hgs_fetch(R, PJ, bid, tid);
              for (int it = bid; it < 2048; it += G) hg_state_item(lds, PJ, DSRAW, HE, it, it + G < 2048 ? it + G : -1, R, tid, lane, wid); }
            { u32x4 R[4]; rts_fetch(R, PJ, bid, tid);
              for (int it = bid; it < 2048; it += G) ret_state_item(lds, PJ, RSRAW, it, it + G < 2048 ? it + G : -1, R, tid, lane, wid); }
            __builtin_amdgcn_s_setprio(0);
        PH_END
        PH_BEGIN(3)
            scan_phase(DSRAW, HE, HST, RSRAW, RST, nseq, L, gtid, NT);
        PH_END
        PH_BEGIN(4)
            if (wid >= 4) __builtin_amdgcn_s_setprio(1);
            { u32x4 R[8]; hgo_fetch(R, PJ, bid, tid);
              for (int it = bid; it < 2048; it += G) hg_out_item(lds, PJ, HST, a.in[5], RET, it, it + G < 2048 ? it + G : -1, R, tid, lane, wid); }
            { u32x4 R[6]; rto_fetch(R, PJ, bid, tid);
              for (int it = bid; it < 2048; it += G) ret_out_item(lds, PJ, RST, a.in[4], RET, it, it + G < 2048 ? it + G : -1, R, tid, lane, wid); }
            __builtin_amdgcn_s_setprio(0);
        PH_END
        PH_BEGIN(5)
            pg8::Gemm gm{RET, WR, MH, D, D}; pg8::StaticOrder S; S.init(MH, D, G, bid);
            EpiMerge2 E{PJ, MG + (size_t)g * MH * D};
            pg8::gemm_phase<EpiMerge2, pg8::StaticOrder, true, true>(lds, gm, S, E);
        PH_END
    }
    {
        const int g = 0; (void)g;
        PH_BEGIN(7)
            pg8::Gemm gm{MG, WO, 2 * MH, D, D}; pg8::StaticOrder S; S.init(2 * MH, D, G, bid);
            EpiRes E{a.in[0], a.in[1], a.out, A2, SS1};
            pg8::gemm_phase<EpiRes, pg8::StaticOrder, true, true>(lds, gm, S, E);
        PH_END
        PH_BEGIN(8)
            pg8::Gemm gm{A2, WF, 2 * MH, NFF2, D}; pg8::StaticOrder S; S.init(2 * MH, NFF2, G, bid);
            EpiFfn E{SS1, a.in[12], a.in[13], GB, SIDE, (LAS float*)(lds + 131072)};
            pg8::gemm_phase<EpiFfn, pg8::StaticOrder, true, true>(lds, gm, S, E);
        PH_END
        PH_BEGIN(9)
            ffn_fixup_phase(SIDE, a.in[12], GB, gtid, NT);
        PH_END
        PH_BEGIN(10)
            pg8::Gemm gm{GB, WD, 2 * MH, D, DFF}; pg8::StaticOrder S; S.init(2 * MH, D, G, bid);
            EpiFinal E{A2, a.out, a.in[15], SS2, (unsigned*)(ws + WS_CNT), lds + 131072 + 4096};
            pg8::gemm_phase<EpiFinal, pg8::StaticOrder, true, true>(lds, gm, S, E);
        PH_END
    }
#undef PH_BEGIN
#undef PH_END
}

extern "C" void kernel_launch(void* const* d_in, const int* in_sizes, int n_in, void* d_out, int out_size, void* d_ws, size_t ws_size, hipStream_t stream) {
    static int grid = 0;
    if (grid == 0) {
        if (n_in != 16 || ws_size < WS_END) { fprintf(stderr, "kernel_launch: unexpected inputs (n_in %d, ws %zu)\n", n_in, ws_size); grid = -1; return; }
        int dev = 0, cus = 0, per_cu = 0;
        hipGetDevice(&dev); hipDeviceGetAttribute(&cus, hipDeviceAttributeMultiprocessorCount, dev);
#if MK_COOP
        hipFuncSetAttribute((const void*)fwd<true>, hipFuncAttributeMaxDynamicSharedMemorySize, LDS_BYTES);
#endif
#if !MK_COOP
        hipFuncSetAttribute((const void*)fwd<false>, hipFuncAttributeMaxDynamicSharedMemorySize, LDS_BYTES);
#endif
        hipOccupancyMaxActiveBlocksPerMultiprocessor(&per_cu, (const void*)fwd<(MK_COOP != 0)>, NTHREADS, LDS_BYTES);
        if (per_cu < 1) { fprintf(stderr, "kernel_launch: occupancy query says %d blocks per CU\n", per_cu); per_cu = 1; }
        (void)hipGetLastError();
        grid = cus * 1;
    }
    if (grid < 0) return;
    Args a{};
    for (int i = 0; i < 16; ++i) a.in[i] = (const float*)d_in[i];
    a.out = (float*)d_out; a.ws = (unsigned char*)d_ws;
#if MK_COOP
    (void)hipMemsetAsync((char*)d_ws + WS_BAR, 0, 131072, stream);
    a.lo = 0; a.hi = NPHASE;
    void* args[] = {&a};
    hipError_t e = hipLaunchCooperativeKernel((const void*)fwd<true>, dim3(grid), dim3(NTHREADS), args, LDS_BYTES, stream);
    if (e != hipSuccess) fprintf(stderr, "cooperative launch failed: %s (grid %d)\n", hipGetErrorString(e), grid);
#else
    for (int s = 0; s < NPHASE; ++s) { a.lo = s; a.hi = s + 1; hipLaunchKernelGGL(fwd<false>, dim3(grid), dim3(NTHREADS), LDS_BYTES, stream, a); }
#endif
}
```

```cpp
#include <hip/hip_runtime.h>
#include <hip/hip_cooperative_groups.h>
#include <cstdio>
#include <cstdint>
namespace cg = cooperative_groups;

#ifndef MK_COOP
#define MK_COOP 1
#endif

#define LAS __attribute__((address_space(3)))
#define DI __device__ __forceinline__
typedef unsigned short bf16_t;
typedef short bf16x8 __attribute__((ext_vector_type(8)));
typedef float f32x4 __attribute__((ext_vector_type(4)));
typedef unsigned u32x4 __attribute__((ext_vector_type(4)));
typedef unsigned u32x2 __attribute__((ext_vector_type(2)));

constexpr int D = 1024, DIN = 6656, DFF = 2816, NFF2 = 5632;
constexpr int MH = 32768;
constexpr float EPS = 1e-6f;
constexpr int NTHREADS = 512;
constexpr int C_RQ = 0, C_RK = 512, C_RV = 1024, C_RG = 1536, C_HQ = 2048, C_HFF = 2560, C_HFB = 3072, C_HI = 3584, C_HG = 4096, C_GA = 4608, C_GB = 5632;

__device__ __forceinline__ float lg2gamma(int h) {
    float r = -0.04580368961312479f;
    r = h == 1 ? -0.02272007650008353f : r; r = h == 2 ? -0.011315313227834146f : r; r = h == 3 ? -0.005646563141142063f : r;
    r = h == 4 ? -0.0028205190623786626f : r; r = h == 5 ? -0.0014095702546713536f : r; r = h == 6 ? -0.0007046129765893727f : r; r = h == 7 ? -0.0003522634716290214f : r;
    return r;
}

constexpr size_t MiB = 1u << 20;
constexpr size_t WS_OML = 0;
constexpr size_t WS_ROT = 1 * MiB;
constexpr size_t WS_WIN = 2 * MiB;
constexpr size_t WS_WR = 15 * MiB;
constexpr size_t WS_WH = 16 * MiB;
constexpr size_t WS_WO = 17 * MiB;
constexpr size_t WS_WF = 19 * MiB;
constexpr size_t WS_WD = 30 * MiB;
constexpr size_t WS_HN = 36 * MiB;
constexpr size_t WS_SS1 = 164 * MiB;
constexpr size_t WS_SS2 = 168 * MiB;
constexpr size_t WS_HE = 168 * MiB;
constexpr size_t WS_RSRAW = 170 * MiB;
constexpr size_t WS_RST = 202 * MiB;
constexpr size_t WS_HST = 234 * MiB;
constexpr size_t WS_PJ = 362 * MiB;
constexpr size_t WS_G = 362 * MiB;
constexpr size_t WS_RET = 778 * MiB;
constexpr size_t WS_MG = 842 * MiB;
constexpr size_t WS_A2 = 170 * MiB;
constexpr size_t WS_SIDE = 970 * MiB;
constexpr size_t WS_END = 990 * MiB;

constexpr size_t WS_CNT = 131072;
constexpr size_t WS_BAR = 65536;
constexpr size_t PJ_HG0 = (size_t)2048 * MH, PJ_G0 = (size_t)4608 * MH;
__host__ __device__ __forceinline__ size_t pj_ret(int stream, int hd) { return ((size_t)(stream * 8 + hd) * MH) * 64; }
__host__ __device__ __forceinline__ size_t pj_hg(int stream, int hd) { return PJ_HG0 + ((size_t)(stream * 4 + hd) * MH) * 128; }
constexpr int LDS_BYTES = 147456;
constexpr int LDS_BARW = 147456 - 64;

DI float bf2f(unsigned short b) { return __uint_as_float((unsigned)b << 16); }
DI float bflo(unsigned u) { return __uint_as_float(u << 16); }
DI float bfhi(unsigned u) { return __uint_as_float(u & 0xffff0000u); }
typedef __bf16 bf16v2_t __attribute__((ext_vector_type(2)));
DI unsigned pk2(float lo, float hi) { bf16v2_t v; v[0] = (__bf16)lo; v[1] = (__bf16)hi; return __builtin_bit_cast(unsigned, v); }
DI unsigned short f2bf(float f) { return (unsigned short)(pk2(f, 0.f) & 0xffffu); }
DI float sigm(float x) { return __builtin_amdgcn_rcpf(1.f + __builtin_amdgcn_exp2f(-1.4426950408889634f * x)); }
DI f32x4 sig4_exp2(f32x4 t) {
    f32x4 d;
#pragma unroll
    for (int j = 0; j < 4; ++j) d[j] = 1.f + __builtin_amdgcn_exp2f(fminf(t[j], 28.853900817779268f));
    const float p01 = d[0] * d[1], p23 = d[2] * d[3];
    const float rr = __builtin_amdgcn_rcpf(p01 * p23);
    const float r01 = rr * p23, r23 = rr * p01;
    return (f32x4){r01 * d[1], r01 * d[0], r23 * d[3], r23 * d[2]};
}
DI int opaque(int x) { asm volatile("" : "+v"(x)); return x; }
DI float wave_sum(float v) {
#pragma unroll
    for (int o = 1; o < 64; o <<= 1) v += __shfl_xor(v, o);
    return v;
}
DI u32x4 pack8(const f32x4 a, const f32x4 b) { u32x4 w; w.x = pk2(a[0], a[1]); w.y = pk2(a[2], a[3]); w.z = pk2(b[0], b[1]); w.w = pk2(b[2], b[3]); return w; }
DI void unpack8(const u32x4 w, f32x4& a, f32x4& b) { a = (f32x4){bflo(w.x), bfhi(w.x), bflo(w.y), bfhi(w.y)}; b = (f32x4){bflo(w.z), bfhi(w.z), bflo(w.w), bfhi(w.w)}; }
#define MFMA16(a, b, c) __builtin_amdgcn_mfma_f32_16x16x32_bf16((a), (b), (c), 0, 0, 0)

namespace pg8 {
constexpr int BM = 256, BK = 64, HALF = 128, HTB = HALF * BK * 2, STAGE_BYTES = 8 * HTB, NXCD = 8, WGM = 8;
__host__ __device__ __forceinline__ int lds_byte(int r, int c) { const int st = (r >> 4) * 2 + (c >> 5), rr = r & 15, cc = c & 31, ob = rr * 64 + cc * 2; return st * 1024 + (ob ^ (((ob >> 9) & 1) << 5)); }
__host__ __device__ __forceinline__ void stage_rc(int b, int& R, int& C) { const int st = b / 1024, sb = b % 1024, swz = sb ^ (((sb >> 9) & 1) << 5); R = (st >> 1) * 16 + swz / 64; C = (st & 1) * 32 + (swz % 64) / 2; }
__host__ __device__ __forceinline__ int perm32(int rho) { const int n = rho >> 4, i = rho & 15; return 8 * (i >> 2) + 4 * n + (i & 3); }

struct Unit { int pm, pn; };
struct Gemm { const bf16_t* A; const bf16_t* Bt; int M, N, K; };

struct StaticOrder {
    int nM, nN, nwg, G, c;
    __host__ __device__ void init(int M, int N, int G_, int c_) { nM = M / BM; nN = N / BM; nwg = nM * nN; G = G_; c = c_; }
    __host__ __device__ bool next(int i, Unit& u) const {
        const long L = (long)i * G + c; if (L >= nwg) return false;
        int wgid = (int)L; { const int q = nwg / NXCD, r = nwg % NXCD, xcd = wgid % NXCD, off = wgid / NXCD; wgid = (xcd < r ? xcd * (q + 1) : r * (q + 1) + (xcd - r) * q) + off; }
        const int nig = WGM * nN, gid = wgid / nig, fm = gid * WGM, gsz = (nM - fm) < WGM ? (nM - fm) : WGM;
        u.pm = fm + ((wgid % nig) % gsz); u.pn = (wgid % nig) / gsz; return true;
    }
    __device__ __forceinline__ void a_ready(const Unit&) const {}
    __device__ __forceinline__ void done(const Unit&) const {}
};

template <class Epi, class Sched, bool ALIGN_EPI = false, bool SP2 = false>
__device__ __forceinline__ void gemm_phase(LAS unsigned char* lds, const Gemm g, const Sched& S, const Epi& E) {
    const int tid = opaque(threadIdx.x), wid = __builtin_amdgcn_readfirstlane(tid >> 6), lane = tid & 63, wr = wid >> 2, wc = wid & 3, fr = lane & 15, fq = lane >> 4;
    const int K = g.K, nt = K / BK;
    unsigned voffA[2], voffB[2];
#pragma unroll
    for (int i = 0; i < 2; ++i) { int R, C; stage_rc(tid * 16 + i * 8192, R, C); const int Rb = Epi::PERM ? ((R & ~31) + perm32(R & 31)) : R;
        voffA[i] = (unsigned)(R * K + C) * 2u; voffB[i] = (unsigned)(Rb * K + C) * 2u; }
    const size_t kstep = (size_t)(BK * 2);
    const size_t hstep = (size_t)HALF * K * 2;
    const size_t tstep = 2 * hstep;
    const unsigned ldsw = (unsigned)wid * 1024u;
    const int aoff = lds_byte(wr * 64 + fr, fq * 8), boff = lds_byte(wc * 32 + fr, fq * 8);
#define PG8_SA(b, h) (((b) * 2 + (h)) * HTB)
#define PG8_SB(b, h) ((4 + (b) * 2 + (h)) * HTB)
#define PG8_STAGE(bufoff, gbase, voff) do { _Pragma("unroll") for (int _i = 0; _i < 2; ++_i) \
        __builtin_amdgcn_global_load_lds((const unsigned*)((const char*)(gbase) + (voff)[_i]), (LAS unsigned*)(lds + (bufoff) + ldsw + _i * 8192), 16, 0, 0); } while (0)
#define PG8_LDA(dst, b, h) do { _Pragma("unroll") for (int m = 0; m < 4; ++m) _Pragma("unroll") for (int k = 0; k < 2; ++k) dst[m][k] = *(const LAS bf16x8*)(lds + PG8_SA(b, h) + aoff + m * 2048 + k * 1024); } while (0)
#define PG8_LDB(dst, b, h) do { _Pragma("unroll") for (int n = 0; n < 2; ++n) _Pragma("unroll") for (int k = 0; k < 2; ++k) dst[n][k] = *(const LAS bf16x8*)(lds + PG8_SB(b, h) + boff + n * 2048 + k * 1024); } while (0)
#define PG8_MMA(ai, bj, At, Bt) do { __builtin_amdgcn_s_setprio(1); _Pragma("unroll") for (int m = 0; m < 4; ++m) _Pragma("unroll") for (int n = 0; n < 2; ++n) _Pragma("unroll") for (int k = 0; k < 2; ++k) \
        acc[ai][bj][m][n] = __builtin_amdgcn_mfma_f32_16x16x32_bf16(Bt[n][k], At[m][k], acc[ai][bj][m][n], 0, 0, 0); __builtin_amdgcn_s_setprio(0); } while (0)
#define PG8_WAIT_V(n) asm volatile("s_waitcnt vmcnt(" #n ")" ::: "memory")
#define PG8_WAIT_L(n) asm volatile("s_waitcnt lgkmcnt(" #n ")" ::: "memory")
#define PG8_BAR __builtin_amdgcn_s_barrier()
#define PG8_SCHED __builtin_amdgcn_sched_barrier(0)
    Unit cur, nxt; int ui = 0;
    if (!S.next(0, cur)) return;
    f32x4 acc[2][2][4][2];
#pragma unroll
    for (int a = 0; a < 2; ++a)
#pragma unroll
        for (int b = 0; b < 2; ++b)
#pragma unroll
            for (int m = 0; m < 4; ++m)
#pragma unroll
                for (int n = 0; n < 2; ++n) acc[a][b][m][n] = (f32x4){0.f, 0.f, 0.f, 0.f};
    bf16x8 At[4][2], B0[2][2], B1[2][2];
    const char* cA = (const char*)g.A + (size_t)cur.pm * tstep; const char* cB = (const char*)g.Bt + (size_t)cur.pn * tstep;
    S.a_ready(cur);
    if constexpr (SP2) {
        PG8_STAGE(PG8_SB(0, 0), cB, voffB); PG8_STAGE(PG8_SB(0, 1), cB + hstep, voffB); PG8_STAGE(PG8_SA(0, 0), cA, voffA); PG8_STAGE(PG8_SA(0, 1), cA + hstep, voffA);
        if (wr == 1) PG8_BAR;
        PG8_WAIT_V(2); PG8_BAR;
        PG8_STAGE(PG8_SB(1, 0), cB + kstep, voffB); PG8_STAGE(PG8_SA(1, 0), cA + kstep, voffA); PG8_STAGE(PG8_SB(1, 1), cB + hstep + kstep, voffB);
        PG8_WAIT_V(6); PG8_BAR;
    } else {
        PG8_STAGE(PG8_SB(0, 0), cB, voffB); PG8_STAGE(PG8_SA(0, 0), cA, voffA); PG8_STAGE(PG8_SB(0, 1), cB + hstep, voffB); PG8_STAGE(PG8_SA(0, 1), cA + hstep, voffA);
        if (wr == 1) PG8_BAR;
        PG8_WAIT_V(4); PG8_BAR;
        PG8_STAGE(PG8_SB(1, 0), cB + kstep, voffB); PG8_STAGE(PG8_SA(1, 0), cA + kstep, voffA); PG8_STAGE(PG8_SB(1, 1), cB + hstep + kstep, voffB);
        PG8_WAIT_V(6); PG8_BAR;
    }
    for (;;) {
        const bool has_next = S.next(ui + 1, nxt);
        const char* nA = has_next ? (const char*)g.A + (size_t)nxt.pm * tstep : cA; const char* nB = has_next ? (const char*)g.Bt + (size_t)nxt.pn * tstep : cB;
        for (int t = 0; t < nt; t += 2) {
            const bool last = (t == nt - 2);
            const char* a1 = cA + (size_t)(t + 1) * kstep;
            const char* a2 = last ? nA : cA + (size_t)(t + 2) * kstep; const char* b2 = last ? nB : cB + (size_t)(t + 2) * kstep;
            const char* a3 = a2 + kstep; const char* b3 = b2 + kstep;
            if (last && has_next) S.a_ready(nxt);
            if constexpr (Epi::MIDK) { if (t == nt / 2) E.mid(acc, cur, wr, wc, fr, fq); }
            if constexpr (SP2) {
            PG8_LDB(B0, 0, 0); PG8_LDB(B1, 0, 1); PG8_SCHED; PG8_LDA(At, 0, 0); PG8_STAGE(PG8_SA(1, 1), a1 + hstep, voffA);
            PG8_WAIT_V(8); PG8_WAIT_L(0); PG8_BAR; PG8_MMA(0, 0, At, B0); PG8_MMA(0, 1, At, B1); PG8_BAR; PG8_SCHED;
            PG8_LDA(At, 0, 1); PG8_STAGE(PG8_SB(0, 0), b2, voffB); PG8_STAGE(PG8_SB(0, 1), b2 + hstep, voffB); PG8_STAGE(PG8_SA(0, 0), a2, voffA);
            PG8_WAIT_V(8); PG8_WAIT_L(0); PG8_BAR; PG8_MMA(1, 0, At, B0); PG8_MMA(1, 1, At, B1); PG8_BAR; PG8_SCHED;
            PG8_LDB(B0, 1, 0); PG8_LDB(B1, 1, 1); PG8_SCHED; PG8_LDA(At, 1, 0); PG8_STAGE(PG8_SA(0, 1), a2 + hstep, voffA);
            PG8_WAIT_V(8); PG8_WAIT_L(0); PG8_BAR; PG8_MMA(0, 0, At, B0); PG8_MMA(0, 1, At, B1); PG8_BAR; PG8_SCHED;
            PG8_LDA(At, 1, 1); PG8_STAGE(PG8_SB(1, 0), b3, voffB); PG8_STAGE(PG8_SB(1, 1), b3 + hstep, voffB); PG8_STAGE(PG8_SA(1, 0), a3, voffA);
            PG8_WAIT_V(8); PG8_WAIT_L(0); PG8_BAR; PG8_MMA(1, 0, At, B0); PG8_MMA(1, 1, At, B1); PG8_BAR; PG8_SCHED;
            } else {
            PG8_LDB(B0, 0, 0); PG8_SCHED; PG8_LDA(At, 0, 0); PG8_STAGE(PG8_SA(1, 1), a1 + hstep, voffA);
            PG8_WAIT_L(8); PG8_BAR; PG8_WAIT_L(0); PG8_MMA(0, 0, At, B0); PG8_BAR; PG8_SCHED;
            PG8_LDB(B1, 0, 1); PG8_STAGE(PG8_SB(0, 0), b2, voffB);
            PG8_BAR; PG8_WAIT_L(0); PG8_MMA(0, 1, At, B1); PG8_BAR;
            PG8_LDA(At, 0, 1); PG8_STAGE(PG8_SA(0, 0), a2, voffA);
            PG8_BAR; PG8_WAIT_L(0); PG8_MMA(1, 0, At, B0); PG8_BAR; PG8_SCHED;
            PG8_STAGE(PG8_SB(0, 1), b2 + hstep, voffB);
            PG8_WAIT_V(6); PG8_BAR; PG8_MMA(1, 1, At, B1); PG8_BAR;
            PG8_LDB(B0, 1, 0); PG8_SCHED; PG8_LDA(At, 1, 0); PG8_STAGE(PG8_SA(0, 1), a2 + hstep, voffA);
            PG8_WAIT_L(8); PG8_BAR; PG8_WAIT_L(0); PG8_MMA(0, 0, At, B0); PG8_BAR; PG8_SCHED;
            PG8_LDB(B1, 1, 1); PG8_STAGE(PG8_SB(1, 0), b3, voffB);
            PG8_BAR; PG8_WAIT_L(0); PG8_MMA(0, 1, At, B1); PG8_BAR;
            PG8_LDA(At, 1, 1); PG8_STAGE(PG8_SA(1, 0), a3, voffA);
            PG8_BAR; PG8_WAIT_L(0); PG8_MMA(1, 0, At, B0); PG8_BAR; PG8_SCHED;
            PG8_STAGE(PG8_SB(1, 1), b3 + hstep, voffB);
            PG8_WAIT_V(6); PG8_BAR; PG8_MMA(1, 1, At, B1); PG8_BAR;
            }
        }
        if constexpr (ALIGN_EPI) { if (wr == 0) PG8_BAR; }
        E(acc, cur, wr, wc, fr, fq); S.done(cur);
        if (!has_next) break;
#pragma unroll
        for (int a = 0; a < 2; ++a)
#pragma unroll
            for (int b = 0; b < 2; ++b)
#pragma unroll
                for (int m = 0; m < 4; ++m)
#pragma unroll
                    for (int n = 0; n < 2; ++n) acc[a][b][m][n] = (f32x4){0.f, 0.f, 0.f, 0.f};
        cur = nxt; cA = nA; cB = nB; ++ui;
        if constexpr (ALIGN_EPI) { if (wr == 1) PG8_BAR; }
    }
    PG8_WAIT_V(0);
    if constexpr (!ALIGN_EPI) { if (wr == 0) PG8_BAR; }
    PG8_BAR;
#undef PG8_SA
#undef PG8_SB
#undef PG8_STAGE
#undef PG8_LDA
#undef PG8_LDB
#undef PG8_MMA
#undef PG8_WAIT_V
#undef PG8_WAIT_L
#undef PG8_BAR
#undef PG8_SCHED
}
}
using pg8::Unit;

typedef f32x4 AccT[2][2][4][2];

struct EpiProj {
    static constexpr bool PERM = true, MIDK = false;
    bf16_t* O; const float* rot; const float* oml; int Lmask;
    DI void operator()(const AccT& acc, const Unit& u, int wr, int wc, int fr, int fq) const {
        const int pn = u.pn;
        const int row0 = u.pm * 256 + wr * 64 + fr;
        size_t base[2]; int rp;
#pragma unroll
        for (int bj = 0; bj < 2; ++bj) {
            if (pn < 8) { rp = 64; base[bj] = pj_ret(pn >> 1, (pn & 1) * 4 + bj * 2 + (wc >> 1)) + (wc & 1) * 32 + 8 * fq; }
            else if (pn < 18) { rp = 128; base[bj] = pj_hg((pn - 8) >> 1, (pn & 1) * 2 + bj) + wc * 32 + 8 * fq; }
            else { rp = 2048; base[bj] = PJ_G0 + (pn - 18) * 256 + bj * 128 + wc * 32 + 8 * fq; }
        }
        int mode;
        if (pn < 4) mode = 4; else if (pn < 6) mode = 0; else if (pn < 10) mode = 1; else if (pn < 14) mode = 3; else if (pn < 16) mode = 0; else if (pn < 18) mode = 1; else mode = 2;
        if (mode == 4) {
            const float sc = pn < 2 ? 1.f : 0.125f;
            const int fi = 16 * (wc & 1) + 4 * fq;
#pragma unroll
            for (int ai = 0; ai < 2; ++ai)
#pragma unroll
                for (int m = 0; m < 4; ++m) {
                    const int row = row0 + ai * 128 + m * 16; const int pos = row & Lmask;
                    const f32x4 cs = *(const f32x4*)(rot + pos * 32 + fi) * sc, sn = *(const f32x4*)(rot + 4096 * 32 + pos * 32 + fi) * sc;
#pragma unroll
                    for (int bj = 0; bj < 2; ++bj) {
                        const f32x4 x1 = acc[ai][bj][m][0], x2 = acc[ai][bj][m][1];
                        const f32x4 o1 = x1 * cs - x2 * sn, o2 = x1 * sn + x2 * cs;
                        *(u32x4*)(O + base[bj] + (size_t)row * rp) = pack8(o1, o2);
                    }
                }
        } else if (mode == 0) {
#pragma unroll
            for (int ai = 0; ai < 2; ++ai)
#pragma unroll
                for (int m = 0; m < 4; ++m) {
                    const size_t row = (size_t)(row0 + ai * 128 + m * 16);
#pragma unroll
                    for (int bj = 0; bj < 2; ++bj) *(u32x4*)(O + base[bj] + row * rp) = pack8(acc[ai][bj][m][0], acc[ai][bj][m][1]);
                }
        } else if (mode == 2) {
#pragma unroll
            for (int ai = 0; ai < 2; ++ai)
#pragma unroll
                for (int m = 0; m < 4; ++m) {
                    const size_t row = (size_t)(row0 + ai * 128 + m * 16);
#pragma unroll
                    for (int bj = 0; bj < 2; ++bj)
                        *(u32x4*)(O + base[bj] + row * rp) = pack8(sig4_exp2(acc[ai][bj][m][0] * -1.4426950408889634f), sig4_exp2(acc[ai][bj][m][1] * -1.4426950408889634f));
                }
        } else {
            f32x4 om[2][2];
#pragma unroll
            for (int bj = 0; bj < 2; ++bj)
#pragma unroll
                for (int n = 0; n < 2; ++n) om[bj][n] = (f32x4){1.f, 1.f, 1.f, 1.f};
            if (mode == 3) {
                const float* op = oml + (pn >= 12 ? 512 : 0) + (pn & 1) * 256 + wc * 32 + 8 * fq;
#pragma unroll
                for (int bj = 0; bj < 2; ++bj)
#pragma unroll
                    for (int n = 0; n < 2; ++n) om[bj][n] = *(const f32x4*)(op + bj * 128 + 4 * n);
            }
            const float sgn = (mode == 3) ? 1.4426950408889634f : -1.4426950408889634f;
#pragma unroll
            for (int ai = 0; ai < 2; ++ai)
#pragma unroll
                for (int m = 0; m < 4; ++m) {
                    const size_t row = (size_t)(row0 + ai * 128 + m * 16);
#pragma unroll
                    for (int bj = 0; bj < 2; ++bj) {
                        f32x4 y[2];
#pragma unroll
                        for (int n = 0; n < 2; ++n) {
                            const f32x4 x = acc[ai][bj][m][n];
                            const f32x4 sg = sig4_exp2(x * sgn);
                            y[n] = ((mode == 1) ? x : om[bj][n]) * sg;
                        }
                        *(u32x4*)(O + base[bj] + row * rp) = pack8(y[0], y[1]);
                    }
                }
        }
    }
};

struct EpiRes {
    static constexpr bool PERM = true, MIDK = false;
    const float* base0; const float* base1; float* out; bf16_t* a2; float* ss;
    DI void operator()(const AccT& acc, const Unit& u, int wr, int wc, int fr, int fq) const {
        const int row0 = u.pm * 256 + wr * 64 + fr, col0 = u.pn * 256 + wc * 32 + 8 * fq;
        const float* base = u.pm < MH / 256 ? base0 : base1 - (size_t)MH * D;
#pragma unroll
        for (int ai = 0; ai < 2; ++ai)
#pragma unroll
            for (int m = 0; m < 4; ++m) {
                const size_t row = (size_t)(row0 + ai * 128 + m * 16);
                float s = 0.f;
#pragma unroll
                for (int bj = 0; bj < 2; ++bj) {
                    const float* bp = base + row * D + col0 + bj * 128;
                    const f32x4 h0 = *(const f32x4*)bp + acc[ai][bj][m][0], h1 = *(const f32x4*)(bp + 4) + acc[ai][bj][m][1];
                    *(u32x4*)(a2 + row * D + col0 + bj * 128) = pack8(h0, h1);
                    s += (h0[0] * h0[0] + h0[1] * h0[1]) + (h0[2] * h0[2] + h0[3] * h0[3]) + (h1[0] * h1[0] + h1[1] * h1[1]) + (h1[2] * h1[2] + h1[3] * h1[3]);
                }
                s += __shfl_xor(s, 16); s += __shfl_xor(s, 32);
                if (fq == 0) ss[row * 16 + u.pn * 4 + wc] = s;
            }
    }
};

template <int CTRL> DI float dpp_mov(float x) { return __builtin_bit_cast(float, __builtin_amdgcn_update_dpp(0, __builtin_bit_cast(int, x), CTRL, 0xf, 0xf, false)); }
template <int CTRL> DI f32x4 dpp4(const f32x4 x) { return (f32x4){dpp_mov<CTRL>(x[0]), dpp_mov<CTRL>(x[1]), dpp_mov<CTRL>(x[2]), dpp_mov<CTRL>(x[3])}; }
template <int CTRL> DI float dpp_movo(float old, float x) { return __builtin_bit_cast(float, __builtin_amdgcn_update_dpp(__builtin_bit_cast(int, old), __builtin_bit_cast(int, x), CTRL, 0xf, 0xf, false)); }
template <int CTRL> DI f32x4 dpp4o(const f32x4 o, const f32x4 x) { return (f32x4){dpp_movo<CTRL>(o[0], x[0]), dpp_movo<CTRL>(o[1], x[1]), dpp_movo<CTRL>(o[2], x[2]), dpp_movo<CTRL>(o[3], x[3])}; }
DI float gelu_tanh(float x) { const float z = 1.5957691216057308f * (x + 0.044715f * x * x * x); return x * sigm(z); }
DI f32x4 gelu_tanh4(f32x4 x) { const f32x4 t = (x + (x * x * x) * 0.044715f) * (-1.5957691216057308f * 1.4426950408889634f); return x * sig4_exp2(t); }
struct EpiFfn {
    static constexpr bool PERM = true, MIDK = false;
    const float* ss; const float* cw; const float* cb; bf16_t* G; float* SIDE; LAS float* HAL;
    DI void operator()(AccT& acc, const Unit& u, int wr, int wc, int fr, int fq) const {
        const int row0 = u.pm * 256 + wr * 64 + fr, c0 = wc * 32 + 8 * fq, f0 = u.pn * 128 + c0;
        LAS float* RSL = HAL + 1024;
        { const int t = opaque(threadIdx.x);
          if (t < 256) { const f32x4* sp = (const f32x4*)(ss + (size_t)(u.pm * 256 + t) * 16); const f32x4 s4 = (sp[0] + sp[1]) + (sp[2] + sp[3]);
                         RSL[t] = rsqrtf(((s4[0] + s4[1]) + (s4[2] + s4[3])) * (1.f / D) + EPS); } }
        asm volatile("s_waitcnt lgkmcnt(0)" ::: "memory"); __builtin_amdgcn_s_barrier(); asm volatile("" ::: "memory");
#pragma unroll
        for (int ai = 0; ai < 2; ++ai)
#pragma unroll
            for (int m = 0; m < 4; ++m) {
                const float rs = RSL[ai * 128 + wr * 64 + m * 16 + fr];
#pragma unroll
                for (int bj = 0; bj < 2; ++bj)
#pragma unroll
                    for (int n = 0; n < 2; ++n) acc[ai][bj][m][n] = acc[ai][bj][m][n] * rs;
            }
#pragma unroll
        for (int ai = 0; ai < 2; ++ai) {
            const int b = 2 * ai + wr;
            if (fr == 0) { *(LAS f32x4*)(HAL + (b * 2 + 0) * 128 + c0) = acc[ai][0][0][0]; *(LAS f32x4*)(HAL + (b * 2 + 0) * 128 + c0 + 4) = acc[ai][0][0][1]; }
            if (fr == 15) { *(LAS f32x4*)(HAL + (b * 2 + 1) * 128 + c0) = acc[ai][0][3][0]; *(LAS f32x4*)(HAL + (b * 2 + 1) * 128 + c0 + 4) = acc[ai][0][3][1]; }
        }
        asm volatile("s_waitcnt lgkmcnt(0)" ::: "memory"); __builtin_amdgcn_s_barrier(); asm volatile("" ::: "memory");
        f32x4 w0[2], w1[2], w2[2], bb[2];
#pragma unroll
        for (int n = 0; n < 2; ++n) { w0[n] = *(const f32x4*)(cw + f0 + 4 * n); w1[n] = *(const f32x4*)(cw + DFF + f0 + 4 * n); w2[n] = *(const f32x4*)(cw + 2 * DFF + f0 + 4 * n); bb[n] = *(const f32x4*)(cb + f0 + 4 * n); }
        const f32x4 zero4 = (f32x4){0.f, 0.f, 0.f, 0.f};
#pragma unroll
        for (int ai = 0; ai < 2; ++ai) {
            const int b = 2 * ai + wr;
            f32x4 ht[2], hb[2];
#pragma unroll
            for (int n = 0; n < 2; ++n) {
                ht[n] = b > 0 ? *(const LAS f32x4*)(HAL + ((b - 1) * 2 + 1) * 128 + c0 + 4 * n) : zero4;
                hb[n] = b < 3 ? *(const LAS f32x4*)(HAL + ((b + 1) * 2 + 0) * 128 + c0 + 4 * n) : zero4;
            }
#pragma unroll
            for (int m = 0; m < 4; ++m) {
                const size_t row = (size_t)(row0 + ai * 128 + m * 16);
                f32x4 x[2], y[2];
#pragma unroll
                for (int n = 0; n < 2; ++n) {
                    const f32x4 cur = acc[ai][0][m][n];
                    f32x4 altp, altn;
                    if (m > 0) altp = dpp4<0x121>(acc[ai][0][m > 0 ? m - 1 : 0][n]); else altp = ht[n];
                    if (m < 3) altn = dpp4<0x12F>(acc[ai][0][m < 3 ? m + 1 : 3][n]); else altn = hb[n];
                    const f32x4 up = dpp4o<0x111>(altp, cur), un = dpp4o<0x101>(altn, cur);
                    x[n] = bb[n] + w0[n] * up + w1[n] * cur + w2[n] * un;
                    y[n] = gelu_tanh4(x[n]) * acc[ai][1][m][n];
                }
                *(u32x4*)(G + row * DFF + f0) = pack8(y[0], y[1]);
                if (m == 0 && b == 0 && fr == 0) {
                    float* sd = SIDE + ((size_t)(u.pm * 2 + 0) * 3) * DFF + f0;
#pragma unroll
                    for (int n = 0; n < 2; ++n) { *(f32x4*)(sd + 4 * n) = x[n]; *(f32x4*)(sd + DFF + 4 * n) = acc[ai][0][m][n]; *(f32x4*)(sd + 2 * DFF + 4 * n) = acc[ai][1][m][n]; }
                }
                if (m == 3 && b == 3 && fr == 15) {
                    float* sd = SIDE + ((size_t)(u.pm * 2 + 1) * 3) * DFF + f0;
#pragma unroll
                    for (int n = 0; n < 2; ++n) { *(f32x4*)(sd + 4 * n) = x[n]; *(f32x4*)(sd + DFF + 4 * n) = acc[ai][0][m][n]; *(f32x4*)(sd + 2 * DFF + 4 * n) = acc[ai][1][m][n]; }
                }
            }
        }
    }
};
DI void ffn_fixup_phase(const float* __restrict__ SIDE, const float* __restrict__ cw, bf16_t* __restrict__ G, int gtid, int NT) {
    constexpr int NCH = DFF / 8;
    for (int idx = gtid; idx < (2 * MH / 256) * 2 * NCH; idx += NT) {
        const int ci = idx % NCH, pw = idx / NCH, which = pw & 1, pm = pw >> 1, f0 = 8 * ci;
        const int row = 256 * pm + (which ? 255 : 0), L = row < MH ? 2048 : 4096, pos = row & (L - 1);
        const float* sd = SIDE + ((size_t)(pm * 2 + which) * 3) * DFF + f0;
        const bool has = which ? (pos != L - 1) : (pos != 0);
        const float* nb = SIDE + ((size_t)((which ? pm + 1 : pm - 1) * 2 + (which ? 0 : 1)) * 3 + 1) * DFF + f0;
        const float* wg = cw + (which ? 2 * DFF : 0) + f0;
        f32x4 y[2];
#pragma unroll
        for (int n = 0; n < 2; ++n) {
            f32x4 x = *(const f32x4*)(sd + 4 * n); const f32x4 vv = *(const f32x4*)(sd + 2 * DFF + 4 * n);
            if (has) x = x + *(const f32x4*)(wg + 4 * n) * *(const f32x4*)(nb + 4 * n);
#pragma unroll
            for (int j = 0; j < 4; ++j) y[n][j] = gelu_tanh(x[j]) * vv[j];
        }
        *(u32x4*)(G + (size_t)row * DFF + f0) = pack8(y[0], y[1]);
    }
}


struct EpiFinal {
    static constexpr bool PERM = true, MIDK = false;
    const bf16_t* base; float* out; const float* wfin; float* xs; unsigned* cnt; LAS unsigned char* lx;
    DI void operator()(AccT& acc, const Unit& u, int wr, int wc, int fr, int fq) const {
        LAS float* PT = (LAS float*)lx; LAS float* ST = (LAS float*)(lx + 4096); volatile LAS unsigned* FL = (volatile LAS unsigned*)(lx + 4096 + 1024);
        const int row0 = u.pm * 256 + wr * 64 + fr, col0 = u.pn * 256 + wc * 32 + 8 * fq;
        const int tid = opaque(threadIdx.x), lane = tid & 63, wid = __builtin_amdgcn_readfirstlane(tid >> 6);
#pragma unroll
        for (int ai = 0; ai < 2; ++ai) {
            u32x4 rb[4][2];
#pragma unroll
            for (int m = 0; m < 4; ++m)
#pragma unroll
                for (int bj = 0; bj < 2; ++bj) rb[m][bj] = *(const u32x4*)(base + (size_t)(row0 + ai * 128 + m * 16) * D + col0 + bj * 128);
            __builtin_amdgcn_sched_barrier(0);
#pragma unroll
            for (int m = 0; m < 4; ++m) {
                const size_t row = (size_t)(row0 + ai * 128 + m * 16);
                float s = 0.f;
#pragma unroll
                for (int bj = 0; bj < 2; ++bj) {
                    f32x4 r0, r1; unpack8(rb[m][bj], r0, r1);
                    const f32x4 h0 = r0 + acc[ai][bj][m][0], h1 = r1 + acc[ai][bj][m][1];
                    acc[ai][bj][m][0] = h0; acc[ai][bj][m][1] = h1;
                    s += (h0[0] * h0[0] + h0[1] * h0[1]) + (h0[2] * h0[2] + h0[3] * h0[3]) + (h1[0] * h1[0] + h1[1] * h1[1]) + (h1[2] * h1[2] + h1[3] * h1[3]);
                }
                s += __shfl_xor(s, 16); s += __shfl_xor(s, 32);
                if (fq == 0) PT[(ai * 128 + wr * 64 + m * 16 + fr) * 4 + wc] = s;
            }
        }
        asm volatile("s_waitcnt lgkmcnt(0)" ::: "memory"); __builtin_amdgcn_s_barrier(); asm volatile("" ::: "memory");
        const int prow = wid * 32 + (lane & 31);
        if (lane < 32) {
            const float tot = (PT[prow * 4 + 0] + PT[prow * 4 + 1]) + (PT[prow * 4 + 2] + PT[prow * 4 + 3]);
            __hip_atomic_store(xs + ((size_t)(u.pm * 256 + prow) * 4 + u.pn), tot, __ATOMIC_RELAXED, __HIP_MEMORY_SCOPE_AGENT);
        }
        asm volatile("s_waitcnt vmcnt(0)" ::: "memory");
        if (lane == 0) __hip_atomic_fetch_add(cnt + 64 * u.pm, 1u, __ATOMIC_RELAXED, __HIP_MEMORY_SCOPE_AGENT);
        if (wid == 0) {
            unsigned spins = 0;
            for (;;) {
                if ((unsigned)__builtin_amdgcn_readfirstlane(__hip_atomic_load(cnt + 64 * u.pm, __ATOMIC_RELAXED, __HIP_MEMORY_SCOPE_AGENT)) >= 32u) break;
                if (++spins > (1u << 22)) break;
                __builtin_amdgcn_s_sleep(2);
            }
            __builtin_amdgcn_fence(__ATOMIC_ACQUIRE, "agent");
            if (lane == 0) FL[0] = 1u;
        }
        asm volatile("s_waitcnt vmcnt(0) lgkmcnt(0)" ::: "memory"); __builtin_amdgcn_s_barrier(); asm volatile("" ::: "memory");
        if (lane < 32) {
            const float* sl = xs + (size_t)(u.pm * 256 + prow) * 4;
            const float t0 = __hip_atomic_load(sl + 0, __ATOMIC_RELAXED, __HIP_MEMORY_SCOPE_AGENT), t1 = __hip_atomic_load(sl + 1, __ATOMIC_RELAXED, __HIP_MEMORY_SCOPE_AGENT);
            const float t2 = __hip_atomic_load(sl + 2, __ATOMIC_RELAXED, __HIP_MEMORY_SCOPE_AGENT), t3 = __hip_atomic_load(sl + 3, __ATOMIC_RELAXED, __HIP_MEMORY_SCOPE_AGENT);
            ST[prow] = rsqrtf(((t0 + t1) + (t2 + t3)) * (1.f / D) + EPS);
        }
        asm volatile("s_waitcnt vmcnt(0) lgkmcnt(0)" ::: "memory"); __builtin_amdgcn_s_barrier(); asm volatile("" ::: "memory");
        f32x4 wv[2][2];
#pragma unroll
        for (int bj = 0; bj < 2; ++bj)
#pragma unroll
            for (int n = 0; n < 2; ++n) wv[bj][n] = *(const f32x4*)(wfin + col0 + bj * 128 + 4 * n);
#pragma unroll
        for (int ai = 0; ai < 2; ++ai)
#pragma unroll
            for (int m = 0; m < 4; ++m) {
                const int rl = ai * 128 + wr * 64 + m * 16 + fr; const float rs = ST[rl];
                float* op = out + (size_t)(u.pm * 256 + rl) * D + col0;
#pragma unroll
                for (int bj = 0; bj < 2; ++bj) { *(f32x4*)(op + bj * 128) = acc[ai][bj][m][0] * rs * wv[bj][0]; *(f32x4*)(op + bj * 128 + 4) = acc[ai][bj][m][1] * rs * wv[bj][1]; }
            }
    }
};


struct EpiMerge2 {
    static constexpr bool PERM = true, MIDK = true;
    const bf16_t* PJ; bf16_t* MG;
    DI void mid(AccT& acc, const Unit& u, int wr, int wc, int fr, int fq) const {
        fr = opaque(fr); fq = opaque(fq);
        const int row0 = u.pm * 256 + wr * 64 + fr, col0 = u.pn * 256 + wc * 32 + 8 * fq;
#pragma unroll
        for (int ai = 0; ai < 2; ++ai)
#pragma unroll
            for (int m = 0; m < 4; ++m) {
                const size_t row = (size_t)(row0 + ai * 128 + m * 16);
#pragma unroll
                for (int bj = 0; bj < 2; ++bj) {
                    f32x4 a0, a1, b0, b1;
                    unpack8(*(const u32x4*)(PJ + PJ_G0 + row * 2048 + col0 + bj * 128), a0, a1);
                    unpack8(*(const u32x4*)(PJ + PJ_G0 + row * 2048 + 1024 + col0 + bj * 128), b0, b1);
#pragma unroll
                    for (int j = 0; j < 4; ++j) { a0[j] *= __builtin_amdgcn_rcpf(fmaxf(b0[j], 1e-30f)); a1[j] *= __builtin_amdgcn_rcpf(fmaxf(b1[j], 1e-30f)); }
                    acc[ai][bj][m][0] = acc[ai][bj][m][0] * a0; acc[ai][bj][m][1] = acc[ai][bj][m][1] * a1;
                }
                asm volatile("" ::: "memory");
            }
    }
    DI void operator()(const AccT& acc, const Unit& u, int wr, int wc, int fr, int fq) const {
        const int row0 = u.pm * 256 + wr * 64 + fr, col0 = u.pn * 256 + wc * 32 + 8 * fq;
#pragma unroll
        for (int ai = 0; ai < 2; ++ai)
#pragma unroll
            for (int m = 0; m < 4; ++m) {
                const size_t row = (size_t)(row0 + ai * 128 + m * 16);
#pragma unroll
                for (int bj = 0; bj < 2; ++bj) {
                    f32x4 b0, b1; unpack8(*(const u32x4*)(PJ + PJ_G0 + row * 2048 + 1024 + col0 + bj * 128), b0, b1);
#pragma unroll
                    for (int j = 0; j < 4; ++j) { b0[j] = fmaxf(b0[j], 1e-30f); b1[j] = fmaxf(b1[j], 1e-30f); }
                    *(u32x4*)(MG + row * D + col0 + bj * 128) = pack8(acc[ai][bj][m][0] * b0, acc[ai][bj][m][1] * b1);
                }
            }
    }
};

template <int MAP> DI int src_col(int p) {
    if (MAP == 1) { if (p < 1024) { const int w = p & 63; const int d = 32 * ((w >> 2) & 1) + 16 * (w >> 5) + 4 * ((w >> 3) & 3) + (w & 3); return (p & ~63) + d; } return p; }
    if (MAP == 2) { const int j = p >> 8, hf = (p >> 7) & 1, c = p & 127; return hf * DFF + 128 * j + c; }
    return p;
}
template <int MAP> DI void p0_item(const float* __restrict__ W, int K, int Nsrc, bf16_t* __restrict__ WT, const float* __restrict__ ks, LAS float* scr, int item, int nblk, int lane, int ldw = 0, int koff = 0) {
    if (ldw == 0) ldw = K;
    const int kb = item / nblk, nb = item % nblk, k0 = 64 * kb, n0 = 32 * nb;
    const int sc = src_col<MAP>(n0 + (lane & 31));
#pragma unroll 8
    for (int i = 0; i < 32; ++i) { const int kk = 2 * i + (lane >> 5); float v = W[(size_t)(k0 + kk) * Nsrc + sc]; if (ks) v *= ks[k0 + kk]; scr[kk * 33 + (lane & 31)] = v; }
    asm volatile("s_waitcnt lgkmcnt(0)" ::: "memory");
    const int c = lane & 7;
#pragma unroll
    for (int j = 0; j < 4; ++j) { const int n = (lane >> 3) + 8 * j; const LAS float* s = scr + (8 * c) * 33 + n;
        u32x4 o; o.x = pk2(s[0 * 33], s[1 * 33]); o.y = pk2(s[2 * 33], s[3 * 33]); o.z = pk2(s[4 * 33], s[5 * 33]); o.w = pk2(s[6 * 33], s[7 * 33]);
        *(u32x4*)(WT + (size_t)(n0 + n) * ldw + koff + k0 + 8 * c) = o; }
    asm volatile("s_waitcnt lgkmcnt(0)" ::: "memory");
}
DI void rms_row_bf16(const float* __restrict__ xrow, const float* __restrict__ w, bf16_t* __restrict__ orow, int lane) {
    const f32x4* xr = (const f32x4*)xrow + lane; f32x4 v[4]; float s = 0.f;
#pragma unroll
    for (int j = 0; j < 4; ++j) { v[j] = xr[64 * j]; s += (v[j][0] * v[j][0] + v[j][1] * v[j][1]) + (v[j][2] * v[j][2] + v[j][3] * v[j][3]); }
    const float rs = rsqrtf(wave_sum(s) * (1.f / D) + EPS);
    u32x2* o8 = (u32x2*)orow + lane;
#pragma unroll
    for (int j = 0; j < 4; ++j) { const f32x4 wv = ((const f32x4*)w)[lane + 64 * j]; const f32x4 y = v[j] * rs * wv; u32x2 o; o.x = pk2(y[0], y[1]); o.y = pk2(y[2], y[3]); o8[64 * j] = o; }
}

constexpr int HGP = 136;
constexpr int RTP = 72;
typedef short s16x4 __attribute__((ext_vector_type(4)));
#ifndef MK_NO_TR
DI bf16x8 ld_tr(const LAS bf16_t* t, int pitch, int row0, int col, int lane) {
    const int r = lane & 15, qq = r >> 2, p = r & 3;
    LAS bf16_t* a = (LAS bf16_t*)t + (row0 + qq) * pitch + (col - r) + 4 * p;
    const s16x4 lo = __builtin_amdgcn_ds_read_tr16_b64_v4i16((LAS s16x4*)a);
    const s16x4 hi = __builtin_amdgcn_ds_read_tr16_b64_v4i16((LAS s16x4*)(a + 4 * pitch));
    return __builtin_shufflevector(lo, hi, 0, 1, 2, 3, 4, 5, 6, 7);
}
#else
DI bf16x8 ld_tr(const LAS bf16_t* t, int pitch, int row0, int col, int lane) {
    bf16x8 v;
#pragma unroll
    for (int e = 0; e < 8; ++e) v[e] = (short)t[(row0 + e) * pitch + col];
    return v;
}
#endif
DI bf16x8 ld_row(const LAS bf16_t* t, int pitch, int row, int col0) { return *(const LAS bf16x8*)(t + row * pitch + col0); }
DI void st4bf(LAS bf16_t* p, float a, float b, float c, float d) { u32x2 w; w.x = pk2(a, b); w.y = pk2(c, d); *(LAS u32x2*)p = w; }

DI void hg_gates(LAS bf16_t* KF, LAS bf16_t* KB, LAS bf16_t* QF, LAS bf16_t* QB, LAS float* SEG, const bool withq, int tid) {
    const int dir = tid >> 8, seg = __builtin_amdgcn_readfirstlane((tid >> 6) & 3), dp = tid & 63;
    LAS unsigned* Kt = (LAS unsigned*)(dir ? KB : KF); LAS unsigned* Qt = (LAS unsigned*)(dir ? QB : QF);
    constexpr int WP = HGP / 2;
    float p0 = 1.f, p1 = 1.f;
#pragma unroll
    for (int s = 0; s < 16; ++s) { const int t = dir ? (16 * seg + 15 - s) : (16 * seg + s); const unsigned w = Kt[t * WP + dp]; p0 *= 1.f - bflo(w); p1 *= 1.f - bfhi(w); }
    SEG[(dir * 4 + seg) * 128 + 2 * dp] = p0; SEG[(dir * 4 + seg) * 128 + 2 * dp + 1] = p1;
    __syncthreads();
    float P0 = 1.f, P1 = 1.f;
#pragma unroll
    for (int s2 = 0; s2 < 4; ++s2) { const bool before = dir ? (s2 > seg) : (s2 < seg); if (before) { P0 *= SEG[(dir * 4 + s2) * 128 + 2 * dp]; P1 *= SEG[(dir * 4 + s2) * 128 + 2 * dp + 1]; } }
#pragma unroll
    for (int s = 0; s < 16; ++s) {
        const int t = dir ? (16 * seg + 15 - s) : (16 * seg + s);
        const unsigned w = Kt[t * WP + dp]; const float k0 = bflo(w), k1 = bfhi(w);
        P0 *= 1.f - k0; P1 *= 1.f - k1;
        Kt[t * WP + dp] = pk2(k0 * __builtin_amdgcn_rcpf(fmaxf(P0, 1e-30f)), k1 * __builtin_amdgcn_rcpf(fmaxf(P1, 1e-30f)));
        if (withq) { const unsigned qw = Qt[t * WP + dp]; Qt[t * WP + dp] = pk2(bflo(qw) * P0, bfhi(qw) * P1); }
    }
    __syncthreads();
}
DI float hg_seg_total(const LAS float* SEG, int dir, int d) { return (SEG[(dir * 4 + 0) * 128 + d] * SEG[(dir * 4 + 1) * 128 + d]) * (SEG[(dir * 4 + 2) * 128 + d] * SEG[(dir * 4 + 3) * 128 + d]); }

DI void hgs_fetch(u32x4 (&R)[6], const bf16_t* __restrict__ PJ, int item, int tid) {
    const int h = item & 3; const size_t toff = (size_t)(item >> 2) * 64 * 128;
#pragma unroll
    for (int j = 0; j < 2; ++j) { const size_t o = toff + 8 * (size_t)(tid + NTHREADS * j);
        R[j] = *(const u32x4*)(PJ + pj_hg(1, h) + o); R[2 + j] = *(const u32x4*)(PJ + pj_hg(2, h) + o); R[4 + j] = *(const u32x4*)(PJ + pj_hg(3, h) + o); }
}
DI void hgo_fetch(u32x4 (&R)[8], const bf16_t* __restrict__ PJ, int item, int tid) {
    const int h = item & 3; const size_t toff = (size_t)(item >> 2) * 64 * 128;
#pragma unroll
    for (int j = 0; j < 2; ++j) { const size_t o = toff + 8 * (size_t)(tid + NTHREADS * j);
        R[j] = *(const u32x4*)(PJ + pj_hg(0, h) + o); R[2 + j] = *(const u32x4*)(PJ + pj_hg(1, h) + o); R[4 + j] = *(const u32x4*)(PJ + pj_hg(2, h) + o); R[6 + j] = *(const u32x4*)(PJ + pj_hg(3, h) + o); }
}
DI void rts_fetch(u32x4 (&R)[4], const bf16_t* __restrict__ PJ, int item, int tid) {
    const int h = item & 7; const size_t toff = (size_t)(item >> 3) * 128 * 64;
#pragma unroll
    for (int j = 0; j < 2; ++j) { const size_t o = toff + 8 * (size_t)(tid + NTHREADS * j);
        R[j] = *(const u32x4*)(PJ + pj_ret(1, h) + o); R[2 + j] = *(const u32x4*)(PJ + pj_ret(2, h) + o); }
}
DI void rto_fetch(u32x4 (&R)[6], const bf16_t* __restrict__ PJ, int item, int tid) {
    const int h = item & 7; const size_t toff = (size_t)(item >> 3) * 128 * 64;
#pragma unroll
    for (int j = 0; j < 2; ++j) { const size_t o = toff + 8 * (size_t)(tid + NTHREADS * j);
        R[j] = *(const u32x4*)(PJ + pj_ret(0, h) + o); R[2 + j] = *(const u32x4*)(PJ + pj_ret(1, h) + o); R[4 + j] = *(const u32x4*)(PJ + pj_ret(2, h) + o); }
}

DI void hg_state_item(LAS unsigned char* lds, const bf16_t* __restrict__ PJ, bf16_t* __restrict__ dS, float* __restrict__ HE, int item, int next, u32x4 (&R)[6], int tid, int lane, int wid) {
    LAS bf16_t* KF = (LAS bf16_t*)lds; LAS bf16_t* KB = KF + 64 * HGP; LAS bf16_t* V = KB + 64 * HGP; LAS float* SEG = (LAS float*)(V + 64 * HGP);
#pragma unroll
    for (int j = 0; j < 2; ++j) { const int i = tid + NTHREADS * j; const int off = (i >> 4) * HGP + 8 * (i & 15);
        *(LAS u32x4*)(KF + off) = R[j]; *(LAS u32x4*)(KB + off) = R[2 + j]; *(LAS u32x4*)(V + off) = R[4 + j]; }
    __syncthreads();
    if (next >= 0) hgs_fetch(R, PJ, next, tid);
    hg_gates(KF, KB, nullptr, nullptr, SEG, false, tid);
    if (tid < 256) { const int dr = tid >> 7, d = tid & 127; HE[((size_t)item * 2 + dr) * 128 + d] = hg_seg_total(SEG, dr, d); }
    const int dir = wid >> 2, wq = wid & 3, r = lane & 15, q = lane >> 4;
    const LAS bf16_t* Kt = dir ? KB : KF;
    f32x4 acc[2][8];
#pragma unroll
    for (int mt = 0; mt < 2; ++mt)
#pragma unroll
        for (int nt = 0; nt < 8; ++nt) acc[mt][nt] = (f32x4){0.f, 0.f, 0.f, 0.f};
#pragma unroll
    for (int ks = 0; ks < 2; ++ks) {
        bf16x8 A[2];
#pragma unroll
        for (int mt = 0; mt < 2; ++mt) A[mt] = ld_tr(Kt, HGP, 32 * ks + 8 * q, 32 * wq + 16 * mt + r, lane);
#pragma unroll
        for (int nt = 0; nt < 8; ++nt) { const bf16x8 B = ld_tr(V, HGP, 32 * ks + 8 * q, 16 * nt + r, lane);
#pragma unroll
            for (int mt = 0; mt < 2; ++mt) acc[mt][nt] = MFMA16(A[mt], B, acc[mt][nt]); }
    }
    LAS bf16_t* STG = (LAS bf16_t*)(lds + 57344);
#pragma unroll
    for (int mt = 0; mt < 2; ++mt) {
        const int dk0 = 32 * wq + 16 * mt + 4 * q; f32x4 e;
#pragma unroll
        for (int jj = 0; jj < 4; ++jj) e[jj] = hg_seg_total(SEG, dir, dk0 + jj);
#pragma unroll
        for (int nt = 0; nt < 8; ++nt) { const int dv = 16 * nt + r; const f32x4 v = acc[mt][nt] * e; st4bf(STG + (dir * 128 + dv) * HGP + dk0, v[0], v[1], v[2], v[3]); }
    }
    __syncthreads();
    {
        bf16_t* dst = dS + (size_t)item * 2 * 128 * 128;
#pragma unroll
        for (int k = 0; k < 8; ++k) { const int ch = tid + NTHREADS * k; const int rowi = ch >> 4, c16 = ch & 15;
            *(u32x4*)(dst + (size_t)rowi * 128 + 8 * c16) = *(const LAS u32x4*)(STG + rowi * HGP + 8 * c16); }
    }
    __syncthreads();
}

DI void hg_out_item(LAS unsigned char* lds, const bf16_t* __restrict__ PJ, const bf16_t* __restrict__ HST, const float* __restrict__ wn, bf16_t* __restrict__ HGO, int item, int next, u32x4 (&R)[8], int tid, int lane, int wid) {
    const int c = item >> 2, h = item & 3; const size_t t0 = (size_t)c * 64;
    LAS bf16_t* QF = (LAS bf16_t*)lds; LAS bf16_t* QB = QF + 64 * HGP; LAS bf16_t* KF = QB + 64 * HGP; LAS bf16_t* KB = KF + 64 * HGP; LAS bf16_t* V = KB + 64 * HGP;
    LAS bf16_t* PF = V + 64 * HGP; LAS bf16_t* PB = PF + 64 * RTP; LAS float* SEG = (LAS float*)(PB + 64 * RTP);
#pragma unroll
    for (int j = 0; j < 2; ++j) { const int i = tid + NTHREADS * j; const int off = (i >> 4) * HGP + 8 * (i & 15);
        *(LAS u32x4*)(QF + off) = R[j]; *(LAS u32x4*)(QB + off) = R[j]; *(LAS u32x4*)(KF + off) = R[2 + j]; *(LAS u32x4*)(KB + off) = R[4 + j]; *(LAS u32x4*)(V + off) = R[6 + j]; }
    __syncthreads();
    if (next >= 0) hgo_fetch(R, PJ, next, tid);
    const int dir = wid >> 2, w4 = wid & 3, r = lane & 15, q = lane >> 4;
    bf16x8 SB[2][4];
#pragma unroll
    for (int dr = 0; dr < 2; ++dr) { const bf16_t* st = HST + ((size_t)item * 2 + dr) * 128 * 128;
#pragma unroll
      for (int ks = 0; ks < 4; ++ks) SB[dr][ks] = *(const bf16x8*)(st + (size_t)(16 * wid + r) * 128 + 32 * ks + 8 * q); }
    hg_gates(KF, KB, QF, QB, SEG, true, tid);
    const LAS bf16_t* Kt = dir ? KB : KF; const LAS bf16_t* Qt = dir ? QB : QF; LAS bf16_t* Pt = dir ? PB : PF;
    {
        f32x4 sc[4];
#pragma unroll
        for (int it = 0; it < 4; ++it) sc[it] = (f32x4){0.f, 0.f, 0.f, 0.f};
#pragma unroll
        for (int ks = 0; ks < 4; ++ks) { const bf16x8 A = ld_row(Kt, HGP, 16 * w4 + r, 32 * ks + 8 * q);
#pragma unroll
            for (int it = 0; it < 4; ++it) { const bf16x8 B = ld_row(Qt, HGP, 16 * it + r, 32 * ks + 8 * q); sc[it] = MFMA16(A, B, sc[it]); } }
#pragma unroll
        for (int it = 0; it < 4; ++it) { const int i = 16 * it + r; float v[4];
#pragma unroll
            for (int jj = 0; jj < 4; ++jj) { const int j = 16 * w4 + 4 * q + jj; const bool keep = dir ? (j >= i) : (j <= i); v[jj] = keep ? sc[it][jj] : 0.f; }
            st4bf(Pt + i * RTP + 16 * w4 + 4 * q, v[0], v[1], v[2], v[3]); }
    }
    __syncthreads();
    f32x4 o[4];
#pragma unroll
    for (int it = 0; it < 4; ++it) o[it] = (f32x4){0.f, 0.f, 0.f, 0.f};
#pragma unroll
    for (int ks = 0; ks < 2; ++ks) {
        const bf16x8 B = ld_tr(V, HGP, 32 * ks + 8 * q, 16 * wid + r, lane);
#pragma unroll
        for (int it = 0; it < 4; ++it) { const bf16x8 Af = ld_row(PF, RTP, 16 * it + r, 32 * ks + 8 * q), Ab = ld_row(PB, RTP, 16 * it + r, 32 * ks + 8 * q);
            o[it] = MFMA16(Af, B, o[it]); o[it] = MFMA16(Ab, B, o[it]); }
    }
#pragma unroll
    for (int dr = 0; dr < 2; ++dr) { const LAS bf16_t* Qd = dr ? QB : QF;
#pragma unroll
        for (int ks = 0; ks < 4; ++ks) {
#pragma unroll
            for (int it = 0; it < 4; ++it) { const bf16x8 A = ld_row(Qd, HGP, 16 * it + r, 32 * ks + 8 * q); o[it] = MFMA16(A, SB[dr][ks], o[it]); } } }
    const int fi = tid >> 3, fcc = tid & 7;
    const bf16_t* gp = PJ + pj_hg(4, h) + (t0 + fi) * 128 + 16 * fcc;
    const u32x4 gw0 = *(const u32x4*)gp, gw1 = *(const u32x4*)(gp + 8);
    __syncthreads();
    LAS float* OX = (LAS float*)lds;
#pragma unroll
    for (int it = 0; it < 4; ++it)
#pragma unroll
        for (int jj = 0; jj < 4; ++jj) OX[(16 * it + 4 * q + jj) * 132 + 16 * wid + r] = o[it][jj];
    __syncthreads();
    {
        const LAS f32x4* op = (const LAS f32x4*)(OX + fi * 132 + 16 * fcc);
        f32x4 v[4]; float ss = 0.f;
#pragma unroll
        for (int k = 0; k < 4; ++k) { v[k] = op[k]; ss += (v[k][0] * v[k][0] + v[k][1] * v[k][1]) + (v[k][2] * v[k][2] + v[k][3] * v[k][3]); }
        ss += __shfl_xor(ss, 1); ss += __shfl_xor(ss, 2); ss += __shfl_xor(ss, 4);
        const float rs = rsqrtf(ss * (1.f / 128.f) + EPS);
        const float* wp = wn + 128 * h + 16 * fcc;
        bf16_t* outp = HGO + (t0 + fi) * 1024 + 512 + 128 * h + 16 * fcc;
#pragma unroll
        for (int hh = 0; hh < 2; ++hh) {
            f32x4 g0, g1; unpack8(hh ? gw1 : gw0, g0, g1);
            const f32x4 w0 = *(const f32x4*)(wp + 8 * hh), w1 = *(const f32x4*)(wp + 8 * hh + 4);
            *(u32x4*)(outp + 8 * hh) = pack8(v[2 * hh] * rs * w0 * g0, v[2 * hh + 1] * rs * w1 * g1);
        }
    }
    __syncthreads();
}

DI void ret_state_item(LAS unsigned char* lds, const bf16_t* __restrict__ PJ, bf16_t* __restrict__ RS, int item, int next, u32x4 (&R)[4], int tid, int lane, int wid) {
    const int h = item & 7; const float lg = lg2gamma(h);
    LAS bf16_t* KF = (LAS bf16_t*)lds; LAS bf16_t* KB = KF + 128 * RTP; LAS bf16_t* V = KB + 128 * RTP;
#pragma unroll
    for (int j = 0; j < 2; ++j) { const int i = tid + NTHREADS * j; const int row = i >> 3, ch = i & 7;
        f32x4 a, b; unpack8(R[j], a, b);
        const float wf = __builtin_amdgcn_exp2f((float)(127 - row) * lg), wb = __builtin_amdgcn_exp2f((float)row * lg);
        *(LAS u32x4*)(KF + row * RTP + 8 * ch) = pack8(a * wf, b * wf); *(LAS u32x4*)(KB + row * RTP + 8 * ch) = pack8(a * wb, b * wb);
        *(LAS u32x4*)(V + row * RTP + 8 * ch) = R[2 + j]; }
    __syncthreads();
    if (next >= 0) rts_fetch(R, PJ, next, tid);
    const int dkt = wid & 3, dvh = wid >> 2, r = lane & 15, q = lane >> 4;
    f32x4 acc[2][2];
#pragma unroll
    for (int a = 0; a < 2; ++a)
#pragma unroll
        for (int b = 0; b < 2; ++b) acc[a][b] = (f32x4){0.f, 0.f, 0.f, 0.f};
#pragma unroll
    for (int ks = 0; ks < 4; ++ks) {
        const bf16x8 Af = ld_tr(KF, RTP, 32 * ks + 8 * q, 16 * dkt + r, lane), Ab = ld_tr(KB, RTP, 32 * ks + 8 * q, 16 * dkt + r, lane);
#pragma unroll
        for (int nt = 0; nt < 2; ++nt) { const bf16x8 B = ld_tr(V, RTP, 32 * ks + 8 * q, 32 * dvh + 16 * nt + r, lane);
            acc[0][nt] = MFMA16(Af, B, acc[0][nt]); acc[1][nt] = MFMA16(Ab, B, acc[1][nt]); }
    }
#pragma unroll
    for (int dr = 0; dr < 2; ++dr)
#pragma unroll
        for (int nt = 0; nt < 2; ++nt) { const int dv = 32 * dvh + 16 * nt + r, dk0 = 16 * dkt + 4 * q; const f32x4 v = acc[dr][nt]; u32x2 w; w.x = pk2(v[0], v[1]); w.y = pk2(v[2], v[3]);
            *(u32x2*)(RS + (((size_t)item * 2 + dr) * 64 + dv) * 64 + dk0) = w; }
    __syncthreads();
}

DI void ret_out_item(LAS unsigned char* lds, const bf16_t* __restrict__ PJ, const bf16_t* __restrict__ RST, const float* __restrict__ wn, bf16_t* __restrict__ RET, int item, int next, u32x4 (&R)[6], int tid, int lane, int wid) {
    const int c = item >> 3, h = item & 7; const size_t t0 = (size_t)c * 128; const float lg = lg2gamma(h);
    LAS bf16_t* Q = (LAS bf16_t*)lds; LAS bf16_t* QF = Q + 128 * RTP; LAS bf16_t* QB = QF + 128 * RTP; LAS bf16_t* K = QB + 128 * RTP; LAS bf16_t* V = K + 128 * RTP; LAS bf16_t* P = V + 128 * RTP;
#pragma unroll
    for (int j = 0; j < 2; ++j) { const int i = tid + NTHREADS * j; const int row = i >> 3, ch = i & 7;
        f32x4 a, b; unpack8(R[j], a, b);
        const float wf = __builtin_amdgcn_exp2f((float)(row + 1) * lg), wb = __builtin_amdgcn_exp2f((float)(128 - row) * lg);
        *(LAS u32x4*)(Q + row * RTP + 8 * ch) = R[j];
        *(LAS u32x4*)(QF + row * RTP + 8 * ch) = pack8(a * wf, b * wf); *(LAS u32x4*)(QB + row * RTP + 8 * ch) = pack8(a * wb, b * wb);
        *(LAS u32x4*)(K + row * RTP + 8 * ch) = R[2 + j]; *(LAS u32x4*)(V + row * RTP + 8 * ch) = R[4 + j]; }
    __syncthreads();
    if (next >= 0) rto_fetch(R, PJ, next, tid);
    const int r = lane & 15, q = lane >> 4;
    const int ih = wid >> 2, dvt = wid & 3;
    bf16x8 SB[2][2];
#pragma unroll
    for (int dr = 0; dr < 2; ++dr) { const bf16_t* st = RST + ((size_t)item * 2 + dr) * 64 * 64;
#pragma unroll
        for (int ks = 0; ks < 2; ++ks) SB[dr][ks] = *(const bf16x8*)(st + (size_t)(16 * dvt + r) * 64 + 32 * ks + 8 * q); }
    {
        f32x4 s[8];
#pragma unroll
        for (int it = 0; it < 8; ++it) s[it] = (f32x4){0.f, 0.f, 0.f, 0.f};
#pragma unroll
        for (int ks = 0; ks < 2; ++ks) { const bf16x8 A = ld_row(K, RTP, 16 * wid + r, 32 * ks + 8 * q);
#pragma unroll
            for (int it = 0; it < 8; ++it) { const bf16x8 B = ld_row(Q, RTP, 16 * it + r, 32 * ks + 8 * q); s[it] = MFMA16(A, B, s[it]); } }
#pragma unroll
        for (int it = 0; it < 8; ++it) { const int i = 16 * it + r; float v[4];
#pragma unroll
            for (int jj = 0; jj < 4; ++jj) { const int j = 16 * wid + 4 * q + jj; const int dd = i > j ? i - j : j - i; v[jj] = s[it][jj] * __builtin_amdgcn_exp2f((float)dd * lg); }
            st4bf(P + i * HGP + 16 * wid + 4 * q, v[0], v[1], v[2], v[3]); }
    }
    __syncthreads();
    f32x4 o[4];
#pragma unroll
    for (int it = 0; it < 4; ++it) o[it] = (f32x4){0.f, 0.f, 0.f, 0.f};
#pragma unroll
    for (int ks = 0; ks < 4; ++ks) { const bf16x8 B = ld_tr(V, RTP, 32 * ks + 8 * q, 16 * dvt + r, lane);
#pragma unroll
        for (int it = 0; it < 4; ++it) { const bf16x8 A = ld_row(P, HGP, 64 * ih + 16 * it + r, 32 * ks + 8 * q); o[it] = MFMA16(A, B, o[it]); } }
#pragma unroll
    for (int dr = 0; dr < 2; ++dr) { const LAS bf16_t* Qd = dr ? QB : QF;
#pragma unroll
        for (int ks = 0; ks < 2; ++ks) {
#pragma unroll
            for (int it = 0; it < 4; ++it) { const bf16x8 A = ld_row(Qd, RTP, 64 * ih + 16 * it + r, 32 * ks + 8 * q); o[it] = MFMA16(A, SB[dr][ks], o[it]); } } }
    const int fi = tid >> 2, fcc = tid & 3;
    const bf16_t* gp = PJ + pj_ret(3, h) + (t0 + fi) * 64 + 16 * fcc;
    const u32x4 gw0 = *(const u32x4*)gp, gw1 = *(const u32x4*)(gp + 8);
    __syncthreads();
    LAS float* OX = (LAS float*)lds;
#pragma unroll
    for (int it = 0; it < 4; ++it)
#pragma unroll
        for (int jj = 0; jj < 4; ++jj) OX[(64 * ih + 16 * it + 4 * q + jj) * 68 + 16 * dvt + r] = o[it][jj];
    __syncthreads();
    {
        const LAS f32x4* op = (const LAS f32x4*)(OX + fi * 68 + 16 * fcc);
        f32x4 v[4]; float ss = 0.f;
#pragma unroll
        for (int k = 0; k < 4; ++k) { v[k] = op[k]; ss += (v[k][0] * v[k][0] + v[k][1] * v[k][1]) + (v[k][2] * v[k][2] + v[k][3] * v[k][3]); }
        ss += __shfl_xor(ss, 1); ss += __shfl_xor(ss, 2);
        const float rs = rsqrtf(ss * (1.f / 64.f) + EPS);
        const float* wp = wn + 64 * h + 16 * fcc;
        bf16_t* outp = RET + (t0 + fi) * 1024 + 64 * h + 16 * fcc;
#pragma unroll
        for (int hh = 0; hh < 2; ++hh) {
            f32x4 g0, g1; unpack8(hh ? gw1 : gw0, g0, g1);
            const f32x4 w0 = *(const f32x4*)(wp + 8 * hh), w1 = *(const f32x4*)(wp + 8 * hh + 4);
            *(u32x4*)(outp + 8 * hh) = pack8(v[2 * hh] * rs * w0 * g0, v[2 * hh + 1] * rs * w1 * g1);
        }
    }
    __syncthreads();
}

DI void scan_phase(const bf16_t* __restrict__ dS, const float* __restrict__ HE, bf16_t* __restrict__ HST, const bf16_t* __restrict__ RSraw, bf16_t* __restrict__ RST, int nseq, int L, int gtid, int NT) {
    {
        const int NC = L / 64;
        for (int v = gtid; v < nseq * 16384; v += NT) {
            const int e = v & 2047, sd = v >> 11, dir = sd & 1, h = (sd >> 1) & 3, seq = sd >> 3, dv = e >> 4, dk8 = (e & 15) * 8;
            f32x4 S0 = (f32x4){0.f, 0.f, 0.f, 0.f}, S1 = S0;
            for (int n0 = 0; n0 < NC; n0 += 8) {
                u32x4 raw[8]; f32x4 e0[8], e1[8];
#pragma unroll
                for (int k = 0; k < 8; ++k) { const int nn = dir ? NC - 1 - (n0 + k) : n0 + k; const size_t it2 = ((size_t)(seq * NC + nn) * 4 + h) * 2 + dir;
                    raw[k] = *(const u32x4*)(dS + (it2 * 128 + dv) * 128 + dk8); e0[k] = *(const f32x4*)(HE + it2 * 128 + dk8); e1[k] = *(const f32x4*)(HE + it2 * 128 + dk8 + 4); }
#pragma unroll
                for (int k = 0; k < 8; ++k) { const int nn = dir ? NC - 1 - (n0 + k) : n0 + k; const size_t it2 = ((size_t)(seq * NC + nn) * 4 + h) * 2 + dir;
                    f32x4 a, b; unpack8(raw[k], a, b);
                    *(u32x4*)(HST + (it2 * 128 + dv) * 128 + dk8) = pack8(S0, S1);
                    S0 = e0[k] * S0 + a; S1 = e1[k] * S1 + b; }
            }
        }
    }
    {
        const int NC = L / 128;
        for (int v = gtid; v < nseq * 8192; v += NT) {
            const int e = v & 511, sd = v >> 9, dir = sd & 1, h = (sd >> 1) & 7, seq = sd >> 4, dv = e >> 3, dk8 = (e & 7) * 8;
            const float dec = __builtin_amdgcn_exp2f(128.f * lg2gamma(h));
            f32x4 S0 = (f32x4){0.f, 0.f, 0.f, 0.f}, S1 = S0;
            for (int n0 = 0; n0 < NC; n0 += 8) {
                u32x4 raw[8];
#pragma unroll
                for (int k = 0; k < 8; ++k) { const int nn = dir ? NC - 1 - (n0 + k) : n0 + k; const size_t it2 = ((size_t)(seq * NC + nn) * 8 + h) * 2 + dir;
                    raw[k] = *(const u32x4*)(RSraw + (it2 * 64 + dv) * 64 + dk8); }
#pragma unroll
                for (int k = 0; k < 8; ++k) { const int nn = dir ? NC - 1 - (n0 + k) : n0 + k; const size_t it2 = ((size_t)(seq * NC + nn) * 8 + h) * 2 + dir;
                    f32x4 a, b; unpack8(raw[k], a, b);
                    *(u32x4*)(RST + (it2 * 64 + dv) * 64 + dk8) = pack8(S0, S1);
                    S0 = S0 * dec + a; S1 = S1 * dec + b; }
            }
        }
    }
}

#define XB_TMO      128
#define XB_XCNT(j)  (256  + 64 * (j))
#define XB_XSUB(j)  (1280 + 64 * (j))
#define XB_XGEN(j)  (2304 + 64 * (j))
#define XB_TOP      3328
#define XB_TOPGEN   3392
#define XCD_BAR_WORDS 3456
#define XB_SPIN_CAP (1u << 18)
__device__ __forceinline__ unsigned xb_ld(unsigned* p)              { return __hip_atomic_load(p, __ATOMIC_RELAXED, __HIP_MEMORY_SCOPE_AGENT); }
__device__ __forceinline__ unsigned xb_add(unsigned* p, unsigned v) { return __hip_atomic_fetch_add(p, v, __ATOMIC_RELAXED, __HIP_MEMORY_SCOPE_AGENT); }
__device__ __forceinline__ unsigned xb_xcc_id() { return (unsigned)__builtin_amdgcn_s_getreg((3 << 11) | 20) & 0xFu; }
#define XB_SPIN(cond, bar) do { unsigned _sp = 0; while (cond) { __builtin_amdgcn_s_sleep(1); \
    if ((++_sp & 255u) == 0u) { if (xb_ld(&(bar)[XB_TMO])) break; if (_sp > XB_SPIN_CAP) { atomicAdd(&(bar)[XB_TMO], 1u); break; } } } } while (0)
struct XcdBarrier { unsigned* bar; unsigned x; volatile LAS unsigned* st; };
__device__ __forceinline__ XcdBarrier xcd_barrier_post(unsigned* bar, volatile LAS unsigned* st) {
    XcdBarrier b; b.bar = bar; b.x = xb_xcc_id(); b.st = st;
    if (threadIdx.x == 0) (void)xb_add(&bar[XB_XCNT(b.x)], 1u);
    return b;
}
__device__ __forceinline__ void xcd_barrier_complete(unsigned* bar, unsigned x, unsigned& nloc, unsigned& nx) {
    const unsigned G = gridDim.x * gridDim.y * gridDim.z;
    unsigned sum, cnt, mine, sp = 0u;
    for (;;) {
        sum = 0u; cnt = 0u; mine = 0u;
#pragma unroll
        for (unsigned j = 0; j < 16; ++j) { const unsigned c = xb_ld(&bar[XB_XCNT(j)]); sum += c; cnt += (c > 0u) ? 1u : 0u; mine = (j == x) ? c : mine; }
        if (sum == G) break;
        __builtin_amdgcn_s_sleep(1);
        if ((++sp & 255u) == 0u) { if (xb_ld(&bar[XB_TMO])) break; if (sp > XB_SPIN_CAP) { atomicAdd(&bar[XB_TMO], 1u); break; } }
    }
    nloc = mine > 0u ? mine : 1u; nx = cnt > 0u ? cnt : 1u;
}
__device__ __forceinline__ void xcd_barrier(const XcdBarrier& b) {
    asm volatile("s_waitcnt vmcnt(0)" ::: "memory");
    __syncthreads();
    if (threadIdx.x == 0) {
        unsigned* bar = b.bar;
        __builtin_amdgcn_s_waitcnt(0);
        unsigned nloc = b.st[0], nx = b.st[1];
        if (nloc == 0u) { xcd_barrier_complete(bar, b.x, nloc, nx); b.st[0] = nloc; b.st[1] = nx; }
        const unsigned old = xb_add(&bar[XB_XSUB(b.x)], 1u);
        const unsigned gen = old / nloc;
        if (old + 1u == (gen + 1u) * nloc) {
            __builtin_amdgcn_fence(__ATOMIC_RELEASE, "agent");
            asm volatile("s_waitcnt vmcnt(0)" ::: "memory");
            const unsigned og = xb_add(&bar[XB_TOP], 1u);
            const unsigned tg = og / nx;
            if (og + 1u == (tg + 1u) * nx) xb_add(&bar[XB_TOPGEN], 1u);
            else XB_SPIN(xb_ld(&bar[XB_TOPGEN]) == tg, bar);
            __builtin_amdgcn_fence(__ATOMIC_ACQUIRE, "agent");
            xb_add(&bar[XB_XGEN(b.x)], 1u);
            asm volatile("s_waitcnt vmcnt(0)" ::: "memory");
        } else {
            XB_SPIN(xb_ld(&bar[XB_XGEN(b.x)]) == gen, bar);
            __builtin_amdgcn_fence(__ATOMIC_ACQUIRE, "agent");
            asm volatile("s_waitcnt vmcnt(0)" ::: "memory");
        }
    }
    __syncthreads();
}
struct Args { const float* in[16]; float* out; unsigned char* ws; int lo, hi; };
constexpr int NPHASE = 15;

template <bool COOP>
__global__ void __launch_bounds__(NTHREADS) fwd(Args a) {
    extern __shared__ __attribute__((aligned(16))) unsigned char lds_raw[];
    LAS unsigned char* lds = (LAS unsigned char*)lds_raw;
    const int G = gridDim.x, bid = blockIdx.x;
    const int NT = G * NTHREADS, NGW = G * 8;
    unsigned char* ws = a.ws;
    float* OML = (float*)(ws + WS_OML); float* ROT = (float*)(ws + WS_ROT);
    bf16_t* WIN = (bf16_t*)(ws + WS_WIN); bf16_t* WR = (bf16_t*)(ws + WS_WR); bf16_t* WH = (bf16_t*)(ws + WS_WH); bf16_t* WO = (bf16_t*)(ws + WS_WO);
    bf16_t* WF = (bf16_t*)(ws + WS_WF); bf16_t* WD = (bf16_t*)(ws + WS_WD); bf16_t* HN = (bf16_t*)(ws + WS_HN);
    float* SS1 = (float*)(ws + WS_SS1); float* SS2 = (float*)(ws + WS_SS2); float* HE = (float*)(ws + WS_HE);
    bf16_t* RSRAW = (bf16_t*)(ws + WS_RSRAW); bf16_t* RST = (bf16_t*)(ws + WS_RST); bf16_t* HST = (bf16_t*)(ws + WS_HST);
    bf16_t* PJ = (bf16_t*)(ws + WS_PJ); bf16_t* GB = (bf16_t*)(ws + WS_G);
    bf16_t* RET = (bf16_t*)(ws + WS_RET); bf16_t* MG = (bf16_t*)(ws + WS_MG); bf16_t* A2 = (bf16_t*)(ws + WS_A2); float* SIDE = (float*)(ws + WS_SIDE);
    const int lo = a.lo, hi = a.hi;
    XcdBarrier xbar; xbar.bar = (unsigned*)(ws + WS_BAR); xbar.x = 0; xbar.st = nullptr;
    if (COOP) {
        volatile LAS unsigned* stw = (volatile LAS unsigned*)(lds + LDS_BARW);
        if (threadIdx.x < 2) stw[threadIdx.x] = 0u;
        __syncthreads();
        xbar = xcd_barrier_post((unsigned*)(ws + WS_BAR), stw);
    }
    int seq = 0;
#ifndef MK_MASK
#define MK_MASK 0xfff
#endif
#define PH_BEGIN(k) if (((MK_MASK >> (k)) & 1) && lo <= seq && seq < hi) { \
    const int tid = opaque(threadIdx.x), lane = tid & 63, wid = __builtin_amdgcn_readfirstlane(tid >> 6); \
    const int gtid = bid * NTHREADS + tid, gw = bid * 8 + wid; (void)lane; (void)gtid; (void)gw;
#define PH_END   if (COOP && seq + 1 < hi) { if (lo < 0) cg::this_grid().sync(); else xcd_barrier(xbar); } } ++seq;

    PH_BEGIN(0)
        LAS float* scr = (LAS float*)(lds + wid * 16384);
        constexpr int I_IN = 16 * 208, I_R = 8 * 32, I_H = 8 * 32, I_O = 16 * 32, I_F = 16 * 176, I_D = 44 * 32;
        constexpr int NIT = I_IN + I_R + I_H + I_O + I_F + I_D;
        for (int it = gw; it < NIT; it += NGW) {
            int r = it;
            if (r < I_IN) { p0_item<1>(a.in[2], 1024, DIN, WIN, nullptr, scr, r, 208, lane); continue; } r -= I_IN;
            if (r < I_R) { p0_item<0>(a.in[6], 512, 1024, WR, nullptr, scr, r, 32, lane, 1024, 0); continue; } r -= I_R;
            if (r < I_H) { p0_item<0>(a.in[7], 512, 1024, WR, nullptr, scr, r, 32, lane, 1024, 512); continue; } r -= I_H;
            if (r < I_O) { p0_item<0>(a.in[8], 1024, 1024, WO, nullptr, scr, r, 32, lane); continue; } r -= I_O;
            if (r < I_F) { p0_item<2>(a.in[11], 1024, NFF2, WF, a.in[10], scr, r, 176, lane); continue; } r -= I_F;
            p0_item<0>(a.in[14], DFF, 1024, WD, nullptr, scr, r, 32, lane);
        }
        for (int i = gtid; i < 4096 * 32; i += NT) {
            const int pos = i >> 5, fi = i & 31;
            const float invf = __builtin_amdgcn_exp2f(-(float)fi * 0.4152410118609203f);
            const float ang = (float)pos * invf;
            const double rev = (double)ang * 0.15915494309189535; const float fr = (float)(rev - floor(rev));
            ROT[i] = __builtin_amdgcn_cosf(fr); ROT[4096 * 32 + i] = __builtin_amdgcn_sinf(fr);
        }
        for (int i = gtid; i < 1024; i += NT) { const float l0 = a.in[3][i], l1 = a.in[3][1024 + i]; OML[i] = sigm(l1 - l0); }
        for (int m = gw; m < MH; m += NGW) {
            const f32x4* x0 = (const f32x4*)(a.in[0] + (size_t)m * D) + lane; const f32x4* x1 = (const f32x4*)(a.in[1] + (size_t)m * D) + lane;
            f32x4 v0[4], v1[4]; float s0 = 0.f, s1 = 0.f;
#pragma unroll
            for (int j = 0; j < 4; ++j) { v0[j] = x0[64 * j]; v1[j] = x1[64 * j]; }
#pragma unroll
            for (int j = 0; j < 4; ++j) { s0 += (v0[j][0] * v0[j][0] + v0[j][1] * v0[j][1]) + (v0[j][2] * v0[j][2] + v0[j][3] * v0[j][3]); s1 += (v1[j][0] * v1[j][0] + v1[j][1] * v1[j][1]) + (v1[j][2] * v1[j][2] + v1[j][3] * v1[j][3]); }
            const float r0 = rsqrtf(wave_sum(s0) * (1.f / D) + EPS), r1 = rsqrtf(wave_sum(s1) * (1.f / D) + EPS);
            u32x2* o0 = (u32x2*)(HN + (size_t)m * D) + lane; u32x2* o1 = (u32x2*)(HN + (size_t)(MH + m) * D) + lane;
#pragma unroll
            for (int j = 0; j < 4; ++j) { const f32x4 wv = ((const f32x4*)a.in[9])[lane + 64 * j]; const f32x4 y0 = v0[j] * r0 * wv, y1 = v1[j] * r1 * wv;
                u32x2 p0; p0.x = pk2(y0[0], y0[1]); p0.y = pk2(y0[2], y0[3]); o0[64 * j] = p0; u32x2 p1; p1.x = pk2(y1[0], y1[1]); p1.y = pk2(y1[2], y1[3]); o1[64 * j] = p1; }
        }
    PH_END

    for (int g = 0; g < 2; ++g) {
        const int L = g ? 4096 : 2048, nseq = g ? 8 : 16;
        const float* xin = a.in[g]; float* outh = a.out + (size_t)g * MH * D;
        bf16_t* DSRAW = (bf16_t*)outh;
        PH_BEGIN(1)
            pg8::Gemm gm{HN + (size_t)g * MH * D, WIN, MH, DIN, D}; pg8::StaticOrder S; S.init(MH, DIN, G, bid);
            EpiProj E{PJ, ROT, OML, L - 1};
            pg8::gemm_phase<EpiProj, pg8::StaticOrder, true, true>(lds, gm, S, E);
        PH_END
        PH_BEGIN(2)
            if (wid >= 4) __builtin_amdgcn_s_setprio(1);
            { u32x4 R[6]; hgs_fetch(R, PJ, bid, tid);
              for (int it = bid; it < 2048; it += G) hg_state_item(lds, PJ, DSRAW, HE, it, it + G < 2048 ? it + G : -1, R, tid, lane, wid); }
            { u32x4 R[4]; rts_fetch(R, PJ, bid, tid);
              for (int it = bid; it < 2048; it += G) ret_state_item(lds, PJ, RSRAW, it, it + G < 2048 ? it + G : -1, R, tid, lane, wid); }
            __builtin_amdgcn_s_setprio(0);
        PH_END
        PH_BEGIN(3)
            scan_phase(DSRAW, HE, HST, RSRAW, RST, nseq, L, gtid, NT);
        PH_END
        PH_BEGIN(4)
            if (wid >= 4) __builtin_amdgcn_s_setprio(1);
            { u32x4 R[8]; hgo_fetch(R, PJ, bid, tid);
              for (int it = bid; it < 2048; it += G) hg_out_item(lds, PJ, HST, a.in[5], RET, it, it + G < 2048 ? it + G : -1, R, tid, lane, wid); }
            { u32x4 R[6]; rto_fetch(R, PJ, bid, tid);
              for (int it = bid; it < 2048; it += G) ret_out_item(lds, PJ, RST, a.in[4], RET, it, it + G < 2048 ? it + G : -1, R, tid, lane, wid); }
            __builtin_amdgcn_s_setprio(0);
        PH_END
        PH_BEGIN(5)
            pg8::Gemm gm{RET, WR, MH, D, D}; pg8::StaticOrder S; S.init(MH, D, G, bid);
            EpiMerge2 E{PJ, MG + (size_t)g * MH * D};
            pg8::gemm_phase<EpiMerge2, pg8::StaticOrder, true, true>(lds, gm, S, E);
        PH_END
    }
    {
        const int g = 0; (void)g;
        PH_BEGIN(7)
            pg8::Gemm gm{MG, WO, 2 * MH, D, D}; pg8::StaticOrder S; S.init(2 * MH, D, G, bid);
            EpiRes E{a.in[0], a.in[1], a.out, A2, SS1};
            pg8::gemm_phase<EpiRes, pg8::StaticOrder, true, true>(lds, gm, S, E);
        PH_END
        PH_BEGIN(8)
            pg8::Gemm gm{A2, WF, 2 * MH, NFF2, D}; pg8::StaticOrder S; S.init(2 * MH, NFF2, G, bid);
            EpiFfn E{SS1, a.in[12], a.in[13], GB, SIDE, (LAS float*)(lds + 131072)};
            pg8::gemm_phase<EpiFfn, pg8::StaticOrder, true, true>(lds, gm, S, E);
        PH_END
        PH_BEGIN(9)
            ffn_fixup_phase(SIDE, a.in[12], GB, gtid, NT);
        PH_END
        PH_BEGIN(10)
            pg8::Gemm gm{GB, WD, 2 * MH, D, DFF}; pg8::StaticOrder S; S.init(2 * MH, D, G, bid);
            EpiFinal E{A2, a.out, a.in[15], SS2, (unsigned*)(ws + WS_CNT), lds + 131072 + 4096};
            pg8::gemm_phase<EpiFinal, pg8::StaticOrder, true, true>(lds, gm, S, E);
        PH_END
    }
#undef PH_BEGIN
#undef PH_END
}

extern "C" void kernel_launch(void* const* d_in, const int* in_sizes, int n_in, void* d_out, int out_size, void* d_ws, size_t ws_size, hipStream_t stream) {
    static int grid = 0;
    if (grid == 0) {
        if (n_in != 16 || ws_size < WS_END) { fprintf(stderr, "kernel_launch: unexpected inputs (n_in %d, ws %zu)\n", n_in, ws_size); grid = -1; return; }
        int dev = 0, cus = 0, per_cu = 0;
        hipGetDevice(&dev); hipDeviceGetAttribute(&cus, hipDeviceAttributeMultiprocessorCount, dev);
#if MK_COOP
        hipFuncSetAttribute((const void*)fwd<true>, hipFuncAttributeMaxDynamicSharedMemorySize, LDS_BYTES);
#endif
#if !MK_COOP
        hipFuncSetAttribute((const void*)fwd<false>, hipFuncAttributeMaxDynamicSharedMemorySize, LDS_BYTES);
#endif
        hipOccupancyMaxActiveBlocksPerMultiprocessor(&per_cu, (const void*)fwd<(MK_COOP != 0)>, NTHREADS, LDS_BYTES);
        if (per_cu < 1) { fprintf(stderr, "kernel_launch: occupancy query says %d blocks per CU\n", per_cu); per_cu = 1; }
        (void)hipGetLastError();
        grid = cus * 1;
    }
    if (grid < 0) return;
    Args a{};
    for (int i = 0; i < 16; ++i) a.in[i] = (const float*)d_in[i];
    a.out = (float*)d_out; a.ws = (unsigned char*)d_ws;
#if MK_COOP
    (void)hipMemsetAsync((char*)d_ws + WS_BAR, 0, 131072, stream);
    a.lo = 0; a.hi = NPHASE;
    void* args[] = {&a};
    hipError_t e = hipLaunchCooperativeKernel((const void*)fwd<true>, dim3(grid), dim3(NTHREADS), args, LDS_BYTES, stream);
    if (e != hipSuccess) fprintf(stderr, "cooperative launch failed: %s (grid %d)\n", hipGetErrorString(e), grid);
#else
    for (int s = 0; s < NPHASE; ++s) { a.lo = s; a.hi = s + 1; hipLaunchKernelGGL(fwd<false>, dim3(grid), dim3(NTHREADS), LDS_BYTES, stream, a); }
#endif
}
```
